# Optimizing an MI355X kernel written in HIP

```python
import jax, jax.numpy as jnp
from jax import lax
import numpy as np

D_MODEL = 1024
BATCH = 8
SEQ = 2048
DEPTH = 1
DEC_BATCH = 128
DEC_SEQ = 1
PAST_LEN = 16384
PAGE_SIZE = 128

MIX_WIDTH = D_MODEL
POOL_WIDTH = MIX_WIDTH // 4
POOL_WINDOWS = (2, 4, 8, 16)
POOL_GROUPS = len(POOL_WINDOWS)
POOL_GROUP_DIM = POOL_WIDTH // POOL_GROUPS
POOL_BUF = max(POOL_WINDOWS) - 1
RET_WIDTH = MIX_WIDTH - POOL_WIDTH
RET_HEAD_DIM = 128
RET_HEADS = RET_WIDTH // RET_HEAD_DIM
RET_CHUNK = 128
ROPE_BASE = 10000.0
D_FF = ((8 * D_MODEL // 3 + 127) // 128) * 128
CONV_W = 3
N_MOD = 6
IN_COLS = POOL_WIDTH + 4 * RET_WIDTH
EPS = 1e-6
F32 = jnp.float32

kernel_name = "hymba_pool_retention_convffn_adaln_step"


def rmsnorm(x, g):
    xf = x.astype(F32)
    y = xf * lax.rsqrt(jnp.mean(xf * xf, axis=-1, keepdims=True) + EPS)
    return (y * g.astype(F32)).astype(x.dtype)


def rope(x, pos):
    half = x.shape[-1] // 2
    inv = ROPE_BASE ** (-jnp.arange(half, dtype=F32) / half)
    ang = pos.astype(F32)[:, None] * inv[None, :]
    cos, sin = jnp.cos(ang), jnp.sin(ang)
    x1, x2 = x[..., :half], x[..., half:]
    return jnp.concatenate([x1 * cos - x2 * sin, x1 * sin + x2 * cos], axis=-1)


def ret_log_gammas():
    return jnp.log(1.0 - jnp.exp2(-5.0 - jnp.arange(RET_HEADS, dtype=F32)))


def pool_mix(u_ext, pos0, w_pool, ls_pool):
    B = u_ext.shape[0]
    L = u_ext.shape[1] - POOL_BUF
    uf = u_ext.astype(F32)
    cs = jnp.concatenate([jnp.zeros_like(uf[:, :1]), jnp.cumsum(uf, axis=1)], axis=1)
    hi = POOL_BUF + 1 + jnp.arange(L)
    pos = pos0 + jnp.arange(L)
    u_new = uf[:, POOL_BUF:]
    outs = []
    for g, w in enumerate(POOL_WINDOWS):
        lo_c, hi_c = g * POOL_GROUP_DIM, (g + 1) * POOL_GROUP_DIM
        csg = cs[:, :, lo_c:hi_c]
        s = csg[:, hi] - csg[:, hi - w]
        cnt = jnp.minimum(w, pos + 1).astype(F32)
        outs.append(s / cnt[None, :, None] - u_new[:, :, lo_c:hi_c])
    p = jnp.stack(outs, axis=2)
    y = jnp.einsum('blgc,gcd->blgd', p, w_pool.astype(F32)).reshape(B, L, POOL_WIDTH)
    return y * ls_pool.astype(F32)


def retention(q, k, v, s0):
    B, H, L, d = q.shape
    C = RET_CHUNK if L % RET_CHUNK == 0 else L
    NC = L // C
    lg = ret_log_gammas()
    j = jnp.arange(C, dtype=F32)
    diff = j[:, None] - j[None, :]
    mask = jnp.where(diff >= 0, jnp.exp(lg[:, None, None] * jnp.maximum(diff, 0.0)), 0.0)
    q_dec = jnp.exp(lg[:, None] * (j + 1.0))[None, :, :, None]
    k_dec = jnp.exp(lg[:, None] * (C - 1.0 - j))[None, :, :, None]
    chunk_dec = jnp.exp(lg * C)[None, :, None, None]

    def step(s, qkv):
        qc, kc, vc = qkv
        att = jnp.einsum('bhid,bhjd->bhij', qc, kc) * mask
        o = (jnp.einsum('bhij,bhjd->bhid', att, vc)
             + jnp.einsum('bhik,bhkv->bhiv', qc, s) * q_dec)
        s_new = s * chunk_dec + jnp.einsum('bhjk,bhjv->bhkv', kc * k_dec, vc)
        return s_new, o

    split = lambda t: jnp.moveaxis(t.reshape(B, H, NC, C, d), 2, 0)
    s_fin, o = lax.scan(step, s0, (split(q), split(k), split(v)))
    o = jnp.moveaxis(o, 0, 2).reshape(B, H, L, d)
    return o, s_fin


def block(x, c, pool_prev, ret_prev, conv_prev, pos0,
          g_mix, g_ffn, w_ada, b_ada, w_in, w_pool, ls_pool, w_out,
          w_ffn_in, conv_w, conv_b, w_ffn_out):
    B, L, _ = x.shape
    mod = (jax.nn.silu(c.astype(F32)) @ w_ada + b_ada).reshape(B, N_MOD, 1, D_MODEL)
    sh_m, sc_m, gt_m, sh_f, sc_f, gt_f = (mod[:, i] for i in range(N_MOD))

    h = rmsnorm(x, g_mix) * (1.0 + sc_m) + sh_m
    z = h @ w_in
    P, R = POOL_WIDTH, RET_WIDTH
    u, q, k, v, gate = jnp.split(z, [P, P + R, P + 2 * R, P + 3 * R], axis=-1)

    u_ext = jnp.concatenate([pool_prev.astype(u.dtype), u], axis=1)
    pool_out = pool_mix(u_ext, pos0, w_pool, ls_pool)

    heads = lambda t: t.reshape(B, L, RET_HEADS, RET_HEAD_DIM).transpose(0, 2, 1, 3).astype(F32)
    pos = pos0 + jnp.arange(L)
    qh = rope(heads(q), pos)
    kh = rope(heads(k), pos) * (RET_HEAD_DIM ** -0.5)
    o, s_new = retention(qh, kh, heads(v), ret_prev.astype(F32))
    mu = jnp.mean(o, axis=-1, keepdims=True)
    var = jnp.mean(jnp.square(o - mu), axis=-1, keepdims=True)
    o = ((o - mu) * lax.rsqrt(var + EPS)).transpose(0, 2, 1, 3).reshape(B, L, RET_WIDTH)
    ret_out = jax.nn.silu(gate.astype(F32)) * o

    mix = jnp.concatenate([pool_out, ret_out], axis=-1) @ w_out
    x = x + gt_m * mix

    h = rmsnorm(x, g_ffn) * (1.0 + sc_f) + sh_f
    a, b = jnp.split(h @ w_ffn_in, [D_FF], axis=-1)
    a_ext = jnp.concatenate([conv_prev.astype(a.dtype), a], axis=1)
    acc = a_ext[:, 0:L] * conv_w[0]
    for i in range(1, CONV_W):
        acc = acc + a_ext[:, i:i + L] * conv_w[i]
    f = (jax.nn.silu(acc + conv_b) * b) @ w_ffn_out
    x = x + gt_f * f
    return x, u_ext[:, -POOL_BUF:], s_new, a_ext[:, -(CONV_W - 1):]


def setup_inputs(seed: int = 0) -> dict:
    key = jax.random.key(seed)
    ks = jax.random.split(key, 24)
    n = lambda k, s, scale: jax.random.normal(k, s, F32) * scale
    return {
        "x_prompt": n(ks[0], (BATCH, SEQ, D_MODEL), 1.0),
        "x_sample": n(ks[1], (DEC_BATCH, DEC_SEQ, D_MODEL), 1.0),
        "c_prompt": n(ks[2], (BATCH, D_MODEL), 1.0),
        "c_sample": n(ks[3], (DEC_BATCH, D_MODEL), 1.0),
        "state_pool": n(ks[4], (DEPTH, DEC_BATCH, POOL_BUF, POOL_WIDTH), 1.0),
        "state_ret": n(ks[5], (DEPTH, DEC_BATCH, RET_HEADS, RET_HEAD_DIM, RET_HEAD_DIM), 0.5),
        "state_conv": n(ks[6], (DEPTH, DEC_BATCH, CONV_W - 1, D_FF), 1.0),
        "g_mix": 1.0 + n(ks[7], (DEPTH, D_MODEL), 0.05),
        "g_ffn": 1.0 + n(ks[8], (DEPTH, D_MODEL), 0.05),
        "w_ada": n(ks[9], (DEPTH, D_MODEL, N_MOD * D_MODEL), 0.5 * D_MODEL ** -0.5),
        "b_ada": n(ks[10], (DEPTH, N_MOD * D_MODEL), 0.01),
        "w_in": n(ks[11], (DEPTH, D_MODEL, IN_COLS), D_MODEL ** -0.5),
        "w_pool": n(ks[12], (DEPTH, POOL_GROUPS, POOL_GROUP_DIM, POOL_GROUP_DIM), POOL_GROUP_DIM ** -0.5),
        "ls_pool": 1.0 + n(ks[13], (DEPTH, POOL_WIDTH), 0.1),
        "w_out": n(ks[14], (DEPTH, MIX_WIDTH, D_MODEL), MIX_WIDTH ** -0.5),
        "w_ffn_in": n(ks[15], (DEPTH, D_MODEL, 2 * D_FF), D_MODEL ** -0.5),
        "conv_w": n(ks[16], (DEPTH, CONV_W, D_FF), CONV_W ** -0.5),
        "conv_b": n(ks[17], (DEPTH, D_FF), 0.01),
        "w_ffn_out": n(ks[18], (DEPTH, D_FF, D_MODEL), D_FF ** -0.5),
        "g_final": 1.0 + n(ks[19], (D_MODEL,), 0.05),
    }


def reference(x_prompt, x_sample, c_prompt, c_sample, state_pool, state_ret, state_conv,
              g_mix, g_ffn, w_ada, b_ada, w_in, w_pool, ls_pool, w_out,
              w_ffn_in, conv_w, conv_b, w_ffn_out, g_final):
    yp, ys = x_prompt, x_sample
    bp = x_prompt.shape[0]
    pp_pool, pp_ret, pp_conv, sp_pool, sp_ret, sp_conv = [], [], [], [], [], []
    for l in range(DEPTH):
        params = (g_mix[l], g_ffn[l], w_ada[l], b_ada[l], w_in[l], w_pool[l], ls_pool[l],
                  w_out[l], w_ffn_in[l], conv_w[l], conv_b[l], w_ffn_out[l])
        yp, a1, a2, a3 = block(yp, c_prompt,
                               jnp.zeros((bp, POOL_BUF, POOL_WIDTH), x_prompt.dtype),
                               jnp.zeros((bp, RET_HEADS, RET_HEAD_DIM, RET_HEAD_DIM), F32),
                               jnp.zeros((bp, CONV_W - 1, D_FF), x_prompt.dtype),
                               0, *params)
        ys, b1, b2, b3 = block(ys, c_sample, state_pool[l], state_ret[l], state_conv[l],
                               PAST_LEN, *params)
        pp_pool.append(a1); pp_ret.append(a2); pp_conv.append(a3)
        sp_pool.append(b1); sp_ret.append(b2); sp_conv.append(b3)
    yp = rmsnorm(yp, g_final)
    ys = rmsnorm(ys, g_final)
    return (yp, ys, jnp.stack(pp_pool), jnp.stack(pp_ret), jnp.stack(pp_conv),
            jnp.stack(sp_pool), jnp.stack(sp_ret), jnp.stack(sp_conv))
```

```cpp
#include <hip/hip_runtime.h>
#include <hip/hip_cooperative_groups.h>
#include <cstdio>
#include <cstdint>
namespace cg = cooperative_groups;

#ifndef MK_MULTI_LAUNCH
#define MK_MULTI_LAUNCH 0
#endif
#ifndef MK_XCD_BARRIER
#define MK_XCD_BARRIER 0
#endif

namespace pg8 {
#define PG8_LAS __attribute__((address_space(3)))
typedef unsigned short bf16_t;
typedef short bf16x8 __attribute__((ext_vector_type(8)));
typedef float f32x4 __attribute__((ext_vector_type(4)));
typedef unsigned u32x4 __attribute__((ext_vector_type(4)));
constexpr int BM = 256, BK = 64, HALF = 128, HTB = HALF * BK * 2  , STAGE_BYTES = 8 * HTB, NXCD = 8, WGM = 8;

__host__ __device__ __forceinline__ int lds_byte(int r, int c) { const int st = (r >> 4) * 2 + (c >> 5), rr = r & 15, cc = c & 31, ob = rr * 64 + cc * 2; return st * 1024 + (ob ^ (((ob >> 9) & 1) << 5)); }
__host__ __device__ __forceinline__ void stage_rc(int b, int& R, int& C) { const int st = b / 1024, sb = b % 1024, swz = sb ^ (((sb >> 9) & 1) << 5); R = (st >> 1) * 16 + swz / 64; C = (st & 1) * 32 + (swz % 64) / 2; }
__host__ __device__ __forceinline__ int perm32(int rho) { const int n = rho >> 4, i = rho & 15; return 8 * (i >> 2) + 4 * n + (i & 3); }

struct Unit { int pm, pn; };
struct Gemm { const bf16_t* A; const bf16_t* Bt; int M, N, K; };

struct StaticOrder {
    int nM, nN, nwg, G, c;
    __host__ __device__ void init(int M, int N, int G_, int c_) { nM = M / BM; nN = N / BM; nwg = nM * nN; G = G_; c = c_; }
    __host__ __device__ bool next(int i, Unit& u) const {
        const long L = (long)i * G + c; if (L >= nwg) return false;
        int wgid = (int)L; { const int q = nwg / NXCD, r = nwg % NXCD, xcd = wgid % NXCD, off = wgid / NXCD; wgid = (xcd < r ? xcd * (q + 1) : r * (q + 1) + (xcd - r) * q) + off; }
        const int nig = WGM * nN, gid = wgid / nig, fm = gid * WGM, gsz = (nM - fm) < WGM ? (nM - fm) : WGM;
        u.pm = fm + ((wgid % nig) % gsz); u.pn = (wgid % nig) / gsz; return true;
    }
    __device__ __forceinline__ void a_ready(const Unit&) const {}
    __device__ __forceinline__ void done(const Unit&) const {}
};

__device__ __forceinline__ unsigned cvt_pk_bf16(float lo, float hi) { unsigned r; asm volatile("v_cvt_pk_bf16_f32 %0, %1, %2" : "=v"(r) : "v"(lo), "v"(hi)); return r; }
template <class Epi, class Sched, bool ALIGN_EPI = false, bool SP2 = false>
__device__ __forceinline__ void gemm_phase(PG8_LAS unsigned char* lds, const Gemm g, const Sched& S, const Epi& E) {
    const int tid = threadIdx.x, wid = __builtin_amdgcn_readfirstlane(tid >> 6), lane = tid & 63, wr = wid >> 2, wc = wid & 3, fr = lane & 15, fq = lane >> 4;
    const int K = g.K, nt = K / BK;
    unsigned voffA[2], voffB[2];
#pragma unroll
    for (int i = 0; i < 2; ++i) { int R, C; stage_rc(tid * 16 + i * 8192, R, C); const int Rb = Epi::PERM ? ((R & ~31) + perm32(R & 31)) : R;
        voffA[i] = (unsigned)(R * K + C) * 2u; voffB[i] = (unsigned)(Rb * K + C) * 2u; }
    const size_t kstep = (size_t)(BK * 2);
    const size_t hstep = (size_t)HALF * K * 2;
    const size_t tstep = 2 * hstep;
    const unsigned ldsw = (unsigned)wid * 1024u;
    const int aoff = lds_byte(wr * 64 + fr, fq * 8), boff = lds_byte(wc * 32 + fr, fq * 8);
#define PG8_SA(b, h) (((b) * 2 + (h)) * HTB)
#define PG8_SB(b, h) ((4 + (b) * 2 + (h)) * HTB)
#define PG8_STAGE(bufoff, gbase, voff) do { _Pragma("unroll") for (int _i = 0; _i < 2; ++_i) \
        __builtin_amdgcn_global_load_lds((const unsigned*)((const char*)(gbase) + (voff)[_i]), (PG8_LAS unsigned*)(lds + (bufoff) + ldsw + _i * 8192), 16, 0, 0); } while (0)
#define PG8_LDA(dst, b, h) do { _Pragma("unroll") for (int m = 0; m < 4; ++m) _Pragma("unroll") for (int k = 0; k < 2; ++k) dst[m][k] = *(const PG8_LAS bf16x8*)(lds + PG8_SA(b, h) + aoff + m * 2048 + k * 1024); } while (0)
#define PG8_LDB(dst, b, h) do { _Pragma("unroll") for (int n = 0; n < 2; ++n) _Pragma("unroll") for (int k = 0; k < 2; ++k) dst[n][k] = *(const PG8_LAS bf16x8*)(lds + PG8_SB(b, h) + boff + n * 2048 + k * 1024); } while (0)
#define PG8_MMA(ai, bj, At, Bt) do { __builtin_amdgcn_s_setprio(1); _Pragma("unroll") for (int m = 0; m < 4; ++m) _Pragma("unroll") for (int n = 0; n < 2; ++n) _Pragma("unroll") for (int k = 0; k < 2; ++k) \
        acc[ai][bj][m][n] = __builtin_amdgcn_mfma_f32_16x16x32_bf16(Bt[n][k], At[m][k], acc[ai][bj][m][n], 0, 0, 0); __builtin_amdgcn_s_setprio(0); } while (0)
#define PG8_WAIT_V(n) asm volatile("s_waitcnt vmcnt(" #n ")" ::: "memory")
#define PG8_WAIT_L(n) asm volatile("s_waitcnt lgkmcnt(" #n ")" ::: "memory")
#define PG8_BAR __builtin_amdgcn_s_barrier()
#define PG8_SCHED __builtin_amdgcn_sched_barrier(0)
    Unit cur, nxt; int ui = 0;
    if (!S.next(0, cur)) return;
    f32x4 acc[2][2][4][2];
#pragma unroll
    for (int a = 0; a < 2; ++a)
#pragma unroll
        for (int b = 0; b < 2; ++b)
#pragma unroll
            for (int m = 0; m < 4; ++m)
#pragma unroll
                for (int n = 0; n < 2; ++n) acc[a][b][m][n] = (f32x4){0.f, 0.f, 0.f, 0.f};
    bf16x8 At[4][2], B0[2][2], B1[2][2];
    const char* cA = (const char*)g.A + (size_t)cur.pm * tstep; const char* cB = (const char*)g.Bt + (size_t)cur.pn * tstep;
    S.a_ready(cur);
    if constexpr (SP2) {
        PG8_STAGE(PG8_SB(0, 0), cB, voffB); PG8_STAGE(PG8_SB(0, 1), cB + hstep, voffB); PG8_STAGE(PG8_SA(0, 0), cA, voffA); PG8_STAGE(PG8_SA(0, 1), cA + hstep, voffA);
        if (wr == 1) PG8_BAR;
        PG8_WAIT_V(2); PG8_BAR;
        PG8_STAGE(PG8_SB(1, 0), cB + kstep, voffB); PG8_STAGE(PG8_SA(1, 0), cA + kstep, voffA); PG8_STAGE(PG8_SB(1, 1), cB + hstep + kstep, voffB);
        PG8_WAIT_V(6); PG8_BAR;
    } else {
        PG8_STAGE(PG8_SB(0, 0), cB, voffB); PG8_STAGE(PG8_SA(0, 0), cA, voffA); PG8_STAGE(PG8_SB(0, 1), cB + hstep, voffB); PG8_STAGE(PG8_SA(0, 1), cA + hstep, voffA);
        if (wr == 1) PG8_BAR;
        PG8_WAIT_V(4); PG8_BAR;
        PG8_STAGE(PG8_SB(1, 0), cB + kstep, voffB); PG8_STAGE(PG8_SA(1, 0), cA + kstep, voffA); PG8_STAGE(PG8_SB(1, 1), cB + hstep + kstep, voffB);
        PG8_WAIT_V(6); PG8_BAR;
    }
    for (;;) {
        const bool has_next = S.next(ui + 1, nxt);
        const char* nA = has_next ? (const char*)g.A + (size_t)nxt.pm * tstep : cA; const char* nB = has_next ? (const char*)g.Bt + (size_t)nxt.pn * tstep : cB;
        for (int t = 0; t < nt; t += 2) {
            const bool last = (t == nt - 2);
            const char* a1 = cA + (size_t)(t + 1) * kstep;
            const char* a2 = last ? nA : cA + (size_t)(t + 2) * kstep; const char* b2 = last ? nB : cB + (size_t)(t + 2) * kstep;
            const char* a3 = a2 + kstep; const char* b3 = b2 + kstep;
            if (last && has_next) S.a_ready(nxt);
            if constexpr (SP2) {
            PG8_LDB(B0, 0, 0); PG8_LDB(B1, 0, 1); PG8_SCHED; PG8_LDA(At, 0, 0); PG8_STAGE(PG8_SA(1, 1), a1 + hstep, voffA);
            PG8_WAIT_V(8); PG8_WAIT_L(0); PG8_BAR; PG8_MMA(0, 0, At, B0); PG8_MMA(0, 1, At, B1); PG8_BAR; PG8_SCHED;
            PG8_LDA(At, 0, 1); PG8_STAGE(PG8_SB(0, 0), b2, voffB); PG8_STAGE(PG8_SB(0, 1), b2 + hstep, voffB); PG8_STAGE(PG8_SA(0, 0), a2, voffA);
            PG8_WAIT_V(8); PG8_WAIT_L(0); PG8_BAR; PG8_MMA(1, 0, At, B0); PG8_MMA(1, 1, At, B1); PG8_BAR; PG8_SCHED;
            PG8_LDB(B0, 1, 0); PG8_LDB(B1, 1, 1); PG8_SCHED; PG8_LDA(At, 1, 0); PG8_STAGE(PG8_SA(0, 1), a2 + hstep, voffA);
            PG8_WAIT_V(8); PG8_WAIT_L(0); PG8_BAR; PG8_MMA(0, 0, At, B0); PG8_MMA(0, 1, At, B1); PG8_BAR; PG8_SCHED;
            PG8_LDA(At, 1, 1); PG8_STAGE(PG8_SB(1, 0), b3, voffB); PG8_STAGE(PG8_SB(1, 1), b3 + hstep, voffB); PG8_STAGE(PG8_SA(1, 0), a3, voffA);
            PG8_WAIT_V(8); PG8_WAIT_L(0); PG8_BAR; PG8_MMA(1, 0, At, B0); PG8_MMA(1, 1, At, B1); PG8_BAR; PG8_SCHED;
            } else {
            PG8_LDB(B0, 0, 0); PG8_SCHED; PG8_LDA(At, 0, 0); PG8_STAGE(PG8_SA(1, 1), a1 + hstep, voffA);
            PG8_WAIT_L(8); PG8_BAR; PG8_WAIT_L(0); PG8_MMA(0, 0, At, B0); PG8_BAR; PG8_SCHED;
            PG8_LDB(B1, 0, 1); PG8_STAGE(PG8_SB(0, 0), b2, voffB);
            PG8_BAR; PG8_WAIT_L(0); PG8_MMA(0, 1, At, B1); PG8_BAR;
            PG8_LDA(At, 0, 1); PG8_STAGE(PG8_SA(0, 0), a2, voffA);
            PG8_BAR; PG8_WAIT_L(0); PG8_MMA(1, 0, At, B0); PG8_BAR; PG8_SCHED;
            PG8_STAGE(PG8_SB(0, 1), b2 + hstep, voffB);
            PG8_WAIT_V(6); PG8_BAR; PG8_MMA(1, 1, At, B1); PG8_BAR;
            PG8_LDB(B0, 1, 0); PG8_SCHED; PG8_LDA(At, 1, 0); PG8_STAGE(PG8_SA(0, 1), a2 + hstep, voffA);
            PG8_WAIT_L(8); PG8_BAR; PG8_WAIT_L(0); PG8_MMA(0, 0, At, B0); PG8_BAR; PG8_SCHED;
            PG8_LDB(B1, 1, 1); PG8_STAGE(PG8_SB(1, 0), b3, voffB);
            PG8_BAR; PG8_WAIT_L(0); PG8_MMA(0, 1, At, B1); PG8_BAR;
            PG8_LDA(At, 1, 1); PG8_STAGE(PG8_SA(1, 0), a3, voffA);
            PG8_BAR; PG8_WAIT_L(0); PG8_MMA(1, 0, At, B0); PG8_BAR; PG8_SCHED;
            PG8_STAGE(PG8_SB(1, 1), b3 + hstep, voffB);
            PG8_WAIT_V(6); PG8_BAR; PG8_MMA(1, 1, At, B1); PG8_BAR;
            }
        }
        if constexpr (ALIGN_EPI) { if (wr == 0) PG8_BAR; }
        if constexpr (!Epi::AFTER_DRAIN) { E(acc, cur, wr, wc, fr, fq); S.done(cur); }
        if (!has_next) break;
#pragma unroll
        for (int a = 0; a < 2; ++a)
#pragma unroll
            for (int b = 0; b < 2; ++b)
#pragma unroll
                for (int m = 0; m < 4; ++m)
#pragma unroll
                    for (int n = 0; n < 2; ++n) acc[a][b][m][n] = (f32x4){0.f, 0.f, 0.f, 0.f};
        cur = nxt; cA = nA; cB = nB; ++ui;
        if constexpr (ALIGN_EPI) { if (wr == 1) PG8_BAR; }
    }
    PG8_WAIT_V(0);
    if constexpr (!ALIGN_EPI) { if (wr == 0) PG8_BAR; }
    PG8_BAR;
    if constexpr (Epi::AFTER_DRAIN) { E.fused(acc, cur, wr, wc, fr, fq, lds, wid, lane); S.done(cur); }
#undef PG8_SA
#undef PG8_SB
#undef PG8_STAGE
#undef PG8_LDA
#undef PG8_LDB
#undef PG8_MMA
#undef PG8_WAIT_V
#undef PG8_WAIT_L
#undef PG8_BAR
#undef PG8_SCHED
}
}

#define LAS __attribute__((address_space(3)))
typedef unsigned short bf16_t;
typedef float f32x4 __attribute__((ext_vector_type(4)));
typedef short bf16x8 __attribute__((ext_vector_type(8)));
typedef unsigned u32x4 __attribute__((ext_vector_type(4)));
typedef unsigned u32x2 __attribute__((ext_vector_type(2)));

constexpr int D = 1024, BP = 8, SEQ = 2048, MP = BP * SEQ, BS = 128, MR = MP + BS, MPAD = 16640;
constexpr int PW = 256, RW = 768, NH = 6, HD = 128, INC = 3328, DFF = 2816, NFF = 5632, NMODC = 6 * D;
constexpr int NCH = SEQ / 128, NBH = BP * NH;
constexpr float EPS = 1e-6f;
constexpr size_t O_YP = 0, O_YS = 16777216, O_PP = 16908288, O_RP = 16939008, O_CP = 17725440, O_PS = 17770496, O_RS = 18262016, O_CS = 30844928, O_END = 31565824;
constexpr size_t MiB = 1u << 20;
constexpr size_t WS_CTL = 0, WS_MOD = 1 * MiB, WS_ROPE = 5 * MiB, WS_VS = 7 * MiB, WS_WIN = 8 * MiB, WS_WOUT = 15 * MiB, WS_WFI = 17 * MiB, WS_WFO = 28 * MiB,
                 WS_HALO = 34 * MiB, WS_RA = 40 * MiB, WS_RB = 73 * MiB, WS_U = 106 * MiB, WS_GATE = 115 * MiB, WS_Q = 140 * MiB, WS_K = 165 * MiB,
                 WS_KT = 190 * MiB, WS_VT = 214 * MiB, WS_G = 140 * MiB, WS_END = 238 * MiB;
constexpr size_t HALO_N = (size_t)65 * 2 * DFF;
constexpr int LDS_BYTES = 147456;
constexpr int LDS_X = 131072;
constexpr int NPHASE = 11;

__device__ __forceinline__ float bf2f(unsigned v) { return __uint_as_float(v << 16); }
__device__ __forceinline__ unsigned f2bf(float f) { unsigned u = __float_as_uint(f); return (u + 0x7fffu + ((u >> 16) & 1u)) >> 16; }
__device__ __forceinline__ unsigned pk2(float lo, float hi) { return pg8::cvt_pk_bf16(lo, hi); }
__device__ __forceinline__ float silu_f(float x) { return x / (1.f + __expf(-x)); }
__device__ __forceinline__ float wave_sum(float v) {
#pragma unroll
    for (int o = 1; o < 64; o <<= 1) v += __shfl_xor(v, o);
    return v;
}
__device__ __forceinline__ float lg2_gamma(int h) { return log2f(1.0f - exp2f(-5.0f - (float)h)); }
__device__ __forceinline__ f32x4 mfma16(bf16x8 a, bf16x8 b, f32x4 c) { return __builtin_amdgcn_mfma_f32_16x16x32_bf16(a, b, c, 0, 0, 0); }
#define BLOCK_SYNC() do { asm volatile("s_waitcnt vmcnt(0) lgkmcnt(0)" ::: "memory"); __builtin_amdgcn_s_barrier(); asm volatile("" ::: "memory"); } while (0)
#define LDS_SYNC() do { asm volatile("s_waitcnt lgkmcnt(0)" ::: "memory"); __builtin_amdgcn_s_barrier(); asm volatile("" ::: "memory"); } while (0)

template <int MAP> __device__ __forceinline__ int wrow_map(int c) {
    if (MAP == 1) return (c & ~127) | (32 * ((c & 63) >> 4) + 16 * ((c & 127) >> 6) + (c & 15));
    if (MAP == 2) { const int a = c < DFF ? c : c - DFF; return 256 * (a >> 7) + (c < DFF ? 0 : 128) + (a & 127); }
    return c;
}
template <int MAP> __device__ __forceinline__ void p0_transpose_item(const float* __restrict__ W, int K, int N, bf16_t* __restrict__ WT, LAS float* scr, int item, int lane) {
    const int nblk = N / 32, kb = item / nblk, nb = item % nblk, k0 = 64 * kb, n0 = 32 * nb;
#pragma unroll 8
    for (int i = 0; i < 32; ++i) { const int kk = 2 * i + (lane >> 5); scr[kk * 33 + (lane & 31)] = W[(size_t)(k0 + kk) * N + n0 + (lane & 31)]; }
    asm volatile("s_waitcnt lgkmcnt(0)" ::: "memory");
    const int c = lane & 7;
#pragma unroll
    for (int j = 0; j < 4; ++j) { const int n = (lane >> 3) + 8 * j; const LAS float* s = scr + (8 * c) * 33 + n;
        u32x4 o; o.x = pk2(s[0 * 33], s[1 * 33]); o.y = pk2(s[2 * 33], s[3 * 33]); o.z = pk2(s[4 * 33], s[5 * 33]); o.w = pk2(s[6 * 33], s[7 * 33]);
        *(u32x4*)(WT + (size_t)wrow_map<MAP>(n0 + n) * K + k0 + 8 * c) = o; }
    asm volatile("s_waitcnt lgkmcnt(0)" ::: "memory");
}

__device__ __forceinline__ void phase0(LAS unsigned char* lds, int G, const float* c_p, const float* c_s, const float* w_ada, const float* b_ada,
                                       const float* w_in, const float* w_out, const float* w_fi, const float* w_fo,
                                       float* mod, float* rope, bf16_t* WTin, bf16_t* WTout, bf16_t* WTfi, bf16_t* WTfo) {
    const int tid = threadIdx.x, lane = tid & 63, w = __builtin_amdgcn_readfirstlane(tid >> 6), fr = lane & 15, fq = lane >> 4;
    LAS float* red = (LAS float*)lds;
    for (int it = blockIdx.x; it < NMODC / 32; it += G) {
        const int n0 = it * 32;
        f32x4 acc[9][2];
#pragma unroll
        for (int mt = 0; mt < 9; ++mt) { acc[mt][0] = (f32x4){0.f, 0.f, 0.f, 0.f}; acc[mt][1] = (f32x4){0.f, 0.f, 0.f, 0.f}; }
#pragma unroll 1
        for (int ks = 0; ks < 4; ++ks) {
            const int k0 = 128 * w + 32 * ks + fq * 8;
            bf16x8 bfr[2];
#pragma unroll
            for (int nt = 0; nt < 2; ++nt) {
                const float* wp = w_ada + (size_t)k0 * NMODC + n0 + 16 * nt + fr;
                float t[8];
#pragma unroll
                for (int j = 0; j < 8; ++j) t[j] = wp[(size_t)j * NMODC];
                u32x4 pk; pk.x = pk2(t[0], t[1]); pk.y = pk2(t[2], t[3]); pk.z = pk2(t[4], t[5]); pk.w = pk2(t[6], t[7]);
                bfr[nt] = __builtin_bit_cast(bf16x8, pk);
            }
#pragma unroll
            for (int mt = 0; mt < 9; ++mt) {
                const int row = 16 * mt + fr;
                u32x4 pk = (u32x4){0u, 0u, 0u, 0u};
                if (row < BP + BS) {
                    const float* cp = (row < BP ? c_p + (size_t)row * D : c_s + (size_t)(row - BP) * D) + k0;
                    const f32x4 a0 = *(const f32x4*)cp, a1 = *(const f32x4*)(cp + 4);
                    pk.x = pk2(silu_f(a0[0]), silu_f(a0[1])); pk.y = pk2(silu_f(a0[2]), silu_f(a0[3]));
                    pk.z = pk2(silu_f(a1[0]), silu_f(a1[1])); pk.w = pk2(silu_f(a1[2]), silu_f(a1[3]));
                }
                const bf16x8 afr = __builtin_bit_cast(bf16x8, pk);
                acc[mt][0] = mfma16(afr, bfr[0], acc[mt][0]);
                acc[mt][1] = mfma16(afr, bfr[1], acc[mt][1]);
            }
        }
#pragma unroll 1
        for (int r = 0; r < 8; ++r) {
            if (w == r) {
#pragma unroll
                for (int mt = 0; mt < 9; ++mt)
#pragma unroll
                    for (int nt = 0; nt < 2; ++nt)
#pragma unroll
                        for (int j = 0; j < 4; ++j) { const int idx = (16 * mt + 4 * fq + j) * 32 + 16 * nt + fr; red[idx] = (r == 0 ? 0.f : red[idx]) + acc[mt][nt][j]; }
            }
            LDS_SYNC();
        }
        for (int idx = tid; idx < (BP + BS) * 32; idx += 512) { const int row = idx >> 5, c = idx & 31; mod[(size_t)row * NMODC + n0 + c] = red[idx] + b_ada[n0 + c]; }
        LDS_SYNC();
    }
    {
        LAS float* scr = (LAS float*)(lds + w * 16384);
        const int gw = blockIdx.x * 8 + w, NGW = G * 8;
        constexpr int I_IN = (D / 64) * (INC / 32), I_OUT = (D / 64) * (D / 32), I_FI = (D / 64) * (NFF / 32), I_FO = (DFF / 64) * (D / 32);
        constexpr int NITEMS = I_IN + I_OUT + I_FI + I_FO;
        for (int it = NITEMS - 1 - gw; it >= 0; it -= NGW) {
            int r = it;
            if (r < I_IN) { p0_transpose_item<1>(w_in, D, INC, WTin, scr, r, lane); continue; } r -= I_IN;
            if (r < I_OUT) { p0_transpose_item<0>(w_out, D, D, WTout, scr, r, lane); continue; } r -= I_OUT;
            if (r < I_FI) { p0_transpose_item<2>(w_fi, D, NFF, WTfi, scr, r, lane); continue; } r -= I_FI;
            p0_transpose_item<0>(w_fo, DFF, D, WTfo, scr, r, lane);
        }
    }
    for (int idx = blockIdx.x * 512 + tid; idx < (SEQ + 1) * 64; idx += G * 512) {
        const int ps = idx >> 6, i = idx & 63;
        const double pos = ps == SEQ ? 16384.0 : (double)ps;
        const double inv = exp(-(double)i * (9.210340371976184 / 64.0));
        double s, c; sincos(pos * inv, &s, &c);
        rope[(size_t)ps * 128 + i] = (float)c; rope[(size_t)ps * 128 + 64 + i] = (float)s;
    }
}

template <int MODE> __device__ __forceinline__ void norm_phase(int G, const float* xp, const float* xs, const float* gvec, const float* mod, int sh_i, int sc_i, bf16_t* H, float* outy) {
    const int tid = threadIdx.x, lane = tid & 63, w = tid >> 6;
    const int gw = blockIdx.x * 8 + w, NGW = G * 8;
    const int nrows = MODE == 2 ? MR : MPAD;
    for (int r = gw; r < nrows; r += NGW) {
        if (MODE != 2 && r >= MR) {
            u32x2* o = (u32x2*)(H + (size_t)r * D) + lane;
#pragma unroll
            for (int j = 0; j < 4; ++j) o[64 * j] = (u32x2){0u, 0u};
            continue;
        }
        const float* src = MODE == 0 ? (r < MP ? xp + (size_t)r * D : xs + (size_t)(r - MP) * D) : outy + (size_t)r * D;
        const f32x4* xr = (const f32x4*)src + lane;
        f32x4 v[4]; float ss = 0.f;
#pragma unroll
        for (int j = 0; j < 4; ++j) { v[j] = xr[64 * j]; ss += (v[j][0] * v[j][0] + v[j][1] * v[j][1]) + (v[j][2] * v[j][2] + v[j][3] * v[j][3]); }
        const float rstd = rsqrtf(wave_sum(ss) * (1.f / D) + EPS);
        if (MODE == 2) {
            f32x4* o = (f32x4*)(outy + (size_t)r * D) + lane;
#pragma unroll
            for (int j = 0; j < 4; ++j) { const f32x4 g4 = ((const f32x4*)gvec)[lane + 64 * j]; o[64 * j] = v[j] * rstd * g4; }
        } else {
            const int nb = r < MP ? (r >> 11) : BP + (r - MP);
            const f32x4* scp = (const f32x4*)(mod + (size_t)nb * NMODC + sc_i * D) + lane;
            const f32x4* shp = (const f32x4*)(mod + (size_t)nb * NMODC + sh_i * D) + lane;
            u32x2* o = (u32x2*)(H + (size_t)r * D) + lane;
#pragma unroll
            for (int j = 0; j < 4; ++j) { const f32x4 g4 = ((const f32x4*)gvec)[lane + 64 * j], sc = scp[64 * j], sh = shp[64 * j];
                const f32x4 y = v[j] * rstd * g4 * (sc + 1.0f) + sh;
                o[64 * j] = (u32x2){pk2(y[0], y[1]), pk2(y[2], y[3])}; }
        }
    }
}

struct EpiIn {
    static constexpr bool PERM = false, AFTER_DRAIN = false;
    bf16_t *U, *Q, *Kb, *KT, *VT, *GATE; float* VS; const float* rope; float* out;
    __device__ __forceinline__ void operator()(const f32x4 (&acc)[2][2][4][2], const pg8::Unit& u, int wr, int wc, int fr, int fq) const {
        const int p0 = 16 * wc + 4 * fq;
#pragma unroll
        for (int bj = 0; bj < 2; ++bj) {
            const int blk = 2 * u.pn + bj;
            const int region = blk < 2 ? 0 : 1 + (blk - 2) / NH, h = blk < 2 ? blk : (blk - 2) % NH;
            const float lg = lg2_gamma(h);
#pragma unroll
            for (int ai = 0; ai < 2; ++ai)
#pragma unroll
                for (int m = 0; m < 4; ++m) {
                    const int r = u.pm * 256 + ai * 128 + wr * 64 + m * 16 + fr;
                    if (r >= MR) continue;
                    const bool samp = r >= MP; const int b = r >> 11, t = r & (SEQ - 1), bs = r - MP;
                    const f32x4 v0 = acc[ai][bj][m][0], v1 = acc[ai][bj][m][1];
                    if (region == 0) {
                        const int c0 = 128 * h + p0;
                        *(u32x2*)(U + (size_t)r * PW + c0) = (u32x2){pk2(v0[0], v0[1]), pk2(v0[2], v0[3])};
                        *(u32x2*)(U + (size_t)r * PW + c0 + 64) = (u32x2){pk2(v1[0], v1[1]), pk2(v1[2], v1[3])};
                        if (samp) { float* o = out + O_PS + ((size_t)bs * 15 + 14) * PW + c0; *(f32x4*)o = v0; *(f32x4*)(o + 64) = v1; }
                        else if (t >= SEQ - 15) { float* o = out + O_PP + ((size_t)b * 15 + (t - (SEQ - 15))) * PW + c0; *(f32x4*)o = v0; *(f32x4*)(o + 64) = v1; }
                    } else if (region == 1 || region == 2) {
                        const float* cs = rope + (size_t)(samp ? SEQ : t) * 128 + p0;
                        const f32x4 c4 = *(const f32x4*)cs, s4 = *(const f32x4*)(cs + 64);
                        f32x4 o1 = v0 * c4 - v1 * s4, o2 = v0 * s4 + v1 * c4;
                        if (region == 2) { o1 = o1 * 0.08838834764831845f; o2 = o2 * 0.08838834764831845f; }
                        bf16_t* dst = (region == 1 ? Q : Kb) + (size_t)r * RW + h * HD + p0;
                        *(u32x2*)dst = (u32x2){pk2(o1[0], o1[1]), pk2(o1[2], o1[3])};
                        *(u32x2*)(dst + 64) = (u32x2){pk2(o2[0], o2[1]), pk2(o2[2], o2[3])};
                        if (region == 2 && !samp) {
                            const float kd = exp2f((float)(127 - (t & 127)) * lg);
                            bf16_t* kt = KT + ((size_t)(b * NH + h) * HD + p0) * SEQ + t;
#pragma unroll
                            for (int e = 0; e < 4; ++e) { kt[(size_t)e * SEQ] = (bf16_t)f2bf(o1[e] * kd); kt[(size_t)(64 + e) * SEQ] = (bf16_t)f2bf(o2[e] * kd); }
                        }
                    } else if (region == 3) {
                        if (samp) { float* o = VS + (size_t)bs * RW + h * HD + p0; *(f32x4*)o = v0; *(f32x4*)(o + 64) = v1; }
                        else {
                            bf16_t* vt = VT + ((size_t)(b * NH + h) * HD + p0) * SEQ + t;
#pragma unroll
                            for (int e = 0; e < 4; ++e) { vt[(size_t)e * SEQ] = (bf16_t)f2bf(v0[e]); vt[(size_t)(64 + e) * SEQ] = (bf16_t)f2bf(v1[e]); }
                        }
                    } else {
                        bf16_t* dst = GATE + (size_t)r * RW + h * HD + p0;
                        *(u32x2*)dst = (u32x2){pk2(silu_f(v0[0]), silu_f(v0[1])), pk2(silu_f(v0[2]), silu_f(v0[3]))};
                        *(u32x2*)(dst + 64) = (u32x2){pk2(silu_f(v1[0]), silu_f(v1[1])), pk2(silu_f(v1[2]), silu_f(v1[3]))};
                    }
                }
        }
    }
};
struct EpiRes {
    static constexpr bool PERM = false, AFTER_DRAIN = false;
    const float *xp, *xs; const float* mod; int gate_i; float* outy; int from_out;
    __device__ __forceinline__ void operator()(const f32x4 (&acc)[2][2][4][2], const pg8::Unit& u, int wr, int wc, int fr, int fq) const {
#pragma unroll
        for (int ai = 0; ai < 2; ++ai)
#pragma unroll
            for (int m = 0; m < 4; ++m) {
                const int r = u.pm * 256 + ai * 128 + wr * 64 + m * 16 + fr;
                if (r >= MR) continue;
                const int nb = r < MP ? (r >> 11) : BP + (r - MP);
                const float* base = from_out ? outy + (size_t)r * D : (r < MP ? xp + (size_t)r * D : xs + (size_t)(r - MP) * D);
                const float* gp = mod + (size_t)nb * NMODC + gate_i * D;
#pragma unroll
                for (int bj = 0; bj < 2; ++bj)
#pragma unroll
                    for (int n = 0; n < 2; ++n) {
                        const int c = u.pn * 256 + bj * 128 + wc * 32 + n * 16 + fq * 4;
                        const f32x4 bv = *(const f32x4*)(base + c), gv = *(const f32x4*)(gp + c);
                        *(f32x4*)(outy + (size_t)r * D + c) = bv + gv * acc[ai][bj][m][n];
                    }
            }
    }
};
struct EpiFfn {
    static constexpr bool PERM = false, AFTER_DRAIN = false;
    bf16_t* Gb; float *AT, *AH, *BH; const float *cw, *cb, *sconv; float* out; LAS float* tail;
    __device__ __forceinline__ void operator()(const f32x4 (&acc)[2][2][4][2], const pg8::Unit& u, int wr, int wc, int fr, int fq) const {
        asm volatile("" : "+v"(fr), "+v"(fq));
        const int lane = fq * 16 + fr, pm = u.pm;
        int ca[2];
#pragma unroll
        for (int n = 0; n < 2; ++n) ca[n] = 128 * u.pn + 32 * wc + 16 * n + 4 * fq;
        if (pm == MP / 256) {
#pragma unroll
            for (int m = 0; m < 4; ++m)
#pragma unroll
                for (int n = 0; n < 2; ++n) {
                    const int bs = wr * 64 + m * 16 + fr;
                    const f32x4 a = acc[0][0][m][n], bb = acc[0][1][m][n];
                    const f32x4 s0 = *(const f32x4*)(sconv + ((size_t)bs * 2 + 0) * DFF + ca[n]), s1 = *(const f32x4*)(sconv + ((size_t)bs * 2 + 1) * DFF + ca[n]);
                    const f32x4 w0 = *(const f32x4*)(cw + ca[n]), w1 = *(const f32x4*)(cw + DFF + ca[n]), w2 = *(const f32x4*)(cw + 2 * DFF + ca[n]), cbv = *(const f32x4*)(cb + ca[n]);
                    const f32x4 cv = w0 * s0 + w1 * s1 + w2 * a + cbv;
                    f32x4 g;
#pragma unroll
                    for (int e = 0; e < 4; ++e) g[e] = silu_f(cv[e]) * bb[e];
                    *(u32x2*)(Gb + (size_t)(MP + bs) * DFF + ca[n]) = (u32x2){pk2(g[0], g[1]), pk2(g[2], g[3])};
                    *(f32x4*)(out + O_CS + ((size_t)bs * 2 + 0) * DFF + ca[n]) = s1;
                    *(f32x4*)(out + O_CS + ((size_t)bs * 2 + 1) * DFF + ca[n]) = a;
                }
            return;
        }
        if (fr >= 14) {
#pragma unroll
            for (int ai = 0; ai < 2; ++ai)
#pragma unroll
                for (int n = 0; n < 2; ++n) {
                    const f32x4 v = acc[ai][0][3][n];
                    *(LAS f32x4*)(tail + (((ai * 2 + wr) * 4 + wc) * 2 + (fr - 14)) * 32 + 16 * n + 4 * fq) = v;
                    if (ai == 1 && wr == 1) {
                        *(f32x4*)(AT + ((size_t)pm * 2 + (fr - 14)) * DFF + ca[n]) = v;
                        if ((pm & 7) == 7) *(f32x4*)(out + O_CP + ((size_t)(pm >> 3) * 2 + (fr - 14)) * DFF + ca[n]) = v;
                    }
                }
        }
        LDS_SYNC();
#pragma unroll
        for (int n = 0; n < 2; ++n) {
            const int can = 128 * u.pn + 32 * wc + 16 * n + 4 * fq;
            const f32x4 w0 = *(const f32x4*)(cw + can), w1 = *(const f32x4*)(cw + DFF + can), w2 = *(const f32x4*)(cw + 2 * DFF + can), cbv = *(const f32x4*)(cb + can);
#pragma unroll
            for (int ai = 0; ai < 2; ++ai) {
                const int s = ai * 2 + wr;
                f32x4 prev = (f32x4){0.f, 0.f, 0.f, 0.f};
                if (s > 0 && fr >= 14) prev = *(const LAS f32x4*)(tail + ((((s - 1) * 4) + wc) * 2 + (fr - 14)) * 32 + 16 * n + 4 * fq);
#pragma unroll
                for (int m = 0; m < 4; ++m) {
                    const int r = pm * 256 + ai * 128 + wr * 64 + m * 16 + fr;
                    const bool top = (s == 0 && m == 0 && fr < 2 && (pm & 7) != 0);
                    const f32x4 cur = acc[ai][0][m][n], bb = acc[ai][1][m][n];
                    f32x4 g;
#pragma unroll
                    for (int e = 0; e < 4; ++e) {
                        const float c1 = __shfl(cur[e], lane - 1), c2 = __shfl(cur[e], lane - 2), q1 = __shfl(prev[e], lane + 15), q2 = __shfl(prev[e], lane + 14);
                        const float a1 = fr >= 1 ? c1 : q1, a2 = fr >= 2 ? c2 : q2;
                        g[e] = silu_f(w0[e] * a2 + w1[e] * a1 + w2[e] * cur[e] + cbv[e]) * bb[e];
                    }
                    if (top) { *(f32x4*)(AH + ((size_t)pm * 2 + fr) * DFF + can) = cur; *(f32x4*)(BH + ((size_t)pm * 2 + fr) * DFF + can) = bb; }
                    else *(u32x2*)(Gb + (size_t)r * DFF + can) = (u32x2){pk2(g[0], g[1]), pk2(g[2], g[3])};
                    prev = cur;
                    asm volatile("" ::: "memory");
                }
            }
        }
    }
};

__device__ __forceinline__ void pool_matvec(LAS float* pbuf, int ntok, int row0, const float* w_pool, const float* ls_pool, bf16_t* MIX) {
    const int tid = threadIdx.x, d = tid & 63, g = (tid >> 6) & 3, half = tid >> 8;
    float wc[64];
#pragma unroll
    for (int c = 0; c < 64; ++c) wc[c] = w_pool[(size_t)(g * 64 + c) * 64 + d];
    const float ls = ls_pool[g * 64 + d];
    const int per = ntok >> 1;
    for (int tt = half * per; tt < (half + 1) * per; ++tt) {
        const LAS f32x4* pp = (const LAS f32x4*)(pbuf + tt * 256 + g * 64);
        float y = 0.f;
#pragma unroll
        for (int c4 = 0; c4 < 16; ++c4) { const f32x4 p4 = pp[c4]; y += p4[0] * wc[4 * c4] + p4[1] * wc[4 * c4 + 1] + p4[2] * wc[4 * c4 + 2] + p4[3] * wc[4 * c4 + 3]; }
        MIX[(size_t)(row0 + tt) * D + g * 64 + d] = (bf16_t)f2bf(y * ls);
    }
}

__device__ __forceinline__ void phase3(LAS unsigned char* lds, int G, const bf16_t* U, const bf16_t* Q, const bf16_t* Kb, const bf16_t* KT, const bf16_t* VT, const bf16_t* GATE,
                                       const float* VS, const float* state_pool, const float* state_ret, const float* w_pool, const float* ls_pool,
                                       bf16_t* SPREV, bf16_t* MIX, float* out) {
    const int tid = threadIdx.x, lane = tid & 63, w = __builtin_amdgcn_readfirstlane(tid >> 6), fr = lane & 15, fq = lane >> 4;
    constexpr int N_SCAN = NBH * 4, N_SRET = BS * NH, N_POOLP = MP / 32, N_POOLS = BS / 8;
    constexpr int NIT = N_SCAN + N_SRET + N_POOLP + N_POOLS;
    for (int it = blockIdx.x; it < NIT; it += G) {
        if (it < N_SCAN) {
            const int bh = it >> 2, dv0 = 32 * (it & 3), h = bh % NH;
            const float gC = exp2f(128.f * lg2_gamma(h));
            const bf16_t* vt = VT + ((size_t)bh * HD + dv0 + fr) * SEQ + fq * 8;
            const bf16_t* kt = KT + ((size_t)bh * HD + 16 * w + fr) * SEQ + fq * 8;
            f32x4 acc[2]; acc[0] = (f32x4){0.f, 0.f, 0.f, 0.f}; acc[1] = acc[0];
            bf16x8 A[2][4], B[4];
#pragma unroll
            for (int ks = 0; ks < 4; ++ks) { B[ks] = *(const bf16x8*)(kt + ks * 32); A[0][ks] = *(const bf16x8*)(vt + ks * 32); A[1][ks] = *(const bf16x8*)(vt + (size_t)16 * SEQ + ks * 32); }
#pragma unroll 1
            for (int c = 0; c < NCH; ++c) {
                bf16_t* sp = SPREV + (((size_t)bh * NCH + c) * HD + dv0 + 4 * fq) * HD + 16 * w + fr;
#pragma unroll
                for (int mt = 0; mt < 2; ++mt)
#pragma unroll
                    for (int j = 0; j < 4; ++j) sp[(size_t)(16 * mt + j) * HD] = (bf16_t)f2bf(acc[mt][j]);
                bf16x8 A2[2][4], B2[4];
                const int cn = c + 1 < NCH ? c + 1 : c;
#pragma unroll
                for (int ks = 0; ks < 4; ++ks) { B2[ks] = *(const bf16x8*)(kt + cn * 128 + ks * 32); A2[0][ks] = *(const bf16x8*)(vt + cn * 128 + ks * 32); A2[1][ks] = *(const bf16x8*)(vt + (size_t)16 * SEQ + cn * 128 + ks * 32); }
                acc[0] = acc[0] * gC; acc[1] = acc[1] * gC;
#pragma unroll
                for (int ks = 0; ks < 4; ++ks) { acc[0] = mfma16(A[0][ks], B[ks], acc[0]); acc[1] = mfma16(A[1][ks], B[ks], acc[1]); }
#pragma unroll
                for (int ks = 0; ks < 4; ++ks) { B[ks] = B2[ks]; A[0][ks] = A2[0][ks]; A[1][ks] = A2[1][ks]; }
            }
            float* o = out + O_RP + ((size_t)bh * HD + 16 * w + fr) * HD + dv0 + 4 * fq;
            *(f32x4*)o = acc[0]; *(f32x4*)(o + 16) = acc[1];
        } else if (it < N_SCAN + N_SRET) {
            const int id = it - N_SCAN, bs = id / NH, h = id % NH, row = MP + bs;
            const float gam = 1.0f - exp2f(-5.0f - (float)h);
            LAS float* red = (LAS float*)lds;
            LAS float* qv = red + 16 * 128;
            if (tid < 256) { const int i = tid & 127; qv[tid] = bf2f((tid < 128 ? Q : Kb)[(size_t)row * RW + h * HD + i]); }
            LDS_SYNC();
            const int dkg = tid >> 5, c4 = tid & 31;
            const f32x4 v4 = *(const f32x4*)(VS + (size_t)bs * RW + h * HD + 4 * c4);
            const float* s0 = state_ret + (((size_t)bs * NH + h) * HD + dkg * 8) * HD + 4 * c4;
            float* sn = out + O_RS + (((size_t)bs * NH + h) * HD + dkg * 8) * HD + 4 * c4;
            f32x4 part = (f32x4){0.f, 0.f, 0.f, 0.f};
#pragma unroll
            for (int i = 0; i < 8; ++i) {
                const f32x4 s = *(const f32x4*)(s0 + (size_t)i * HD);
                const float qd = qv[dkg * 8 + i], kd = qv[128 + dkg * 8 + i];
                part = part + s * qd;
                *(f32x4*)(sn + (size_t)i * HD) = s * gam + v4 * kd;
            }
            *(LAS f32x4*)(red + dkg * 128 + 4 * c4) = part;
            LDS_SYNC();
            if (w == 0) {
                float qk = 0.f;
#pragma unroll
                for (int i = 0; i < 2; ++i) qk += qv[lane + 64 * i] * qv[128 + lane + 64 * i];
                qk = wave_sum(qk);
                float o[2], s1 = 0.f;
#pragma unroll
                for (int i = 0; i < 2; ++i) { const int dv = lane + 64 * i; float a = 0.f;
#pragma unroll
                    for (int g = 0; g < 16; ++g) a += red[g * 128 + dv];
                    o[i] = qk * VS[(size_t)bs * RW + h * HD + dv] + gam * a; s1 += o[i]; }
                const float mu = wave_sum(s1) * (1.f / HD);
                float s2 = 0.f;
#pragma unroll
                for (int i = 0; i < 2; ++i) { o[i] -= mu; s2 += o[i] * o[i]; }
                const float rstd = rsqrtf(wave_sum(s2) * (1.f / HD) + EPS);
#pragma unroll
                for (int i = 0; i < 2; ++i) { const int dv = lane + 64 * i;
                    MIX[(size_t)row * D + PW + h * HD + dv] = (bf16_t)f2bf(o[i] * rstd * bf2f(GATE[(size_t)row * RW + h * HD + dv])); }
            }
            LDS_SYNC();
        } else if (it < N_SCAN + N_SRET + N_POOLP) {
            const int tile = it - N_SCAN - N_SRET, r0 = tile * 32, t0 = r0 & (SEQ - 1);
            LAS float* ub = (LAS float*)lds;
            LAS float* pb = ub + 47 * 256;
            for (int idx = tid; idx < 47 * 256; idx += 512) { const int rr = idx >> 8, ch = idx & 255, t = t0 - 15 + rr;
                ub[idx] = t >= 0 ? bf2f(U[(size_t)(r0 - 15 + rr) * PW + ch]) : 0.f; }
            LDS_SYNC();
            { const int ch = tid & 255, g = ch >> 6, wn = 2 << g;
#pragma unroll 1
              for (int i = 0; i < 16; ++i) { const int tt = (tid >> 8) * 16 + i; float s = 0.f;
                  for (int k = 0; k < wn; ++k) s += ub[(15 + tt - k) * 256 + ch];
                  const int cnt = min(wn, t0 + tt + 1);
                  pb[tt * 256 + ch] = s / (float)cnt - ub[(15 + tt) * 256 + ch]; } }
            LDS_SYNC();
            pool_matvec(pb, 32, r0, w_pool, ls_pool, MIX);
            LDS_SYNC();
        } else {
            const int s0i = (it - N_SCAN - N_SRET - N_POOLP) * 8;
            LAS float* pb = (LAS float*)lds;
            { const int ch = tid & 255, g = ch >> 6, wn = 2 << g;
#pragma unroll 1
              for (int i = 0; i < 4; ++i) { const int sidx = (tid >> 8) * 4 + i, bs = s0i + sidx;
                  const float un = bf2f(U[(size_t)(MP + bs) * PW + ch]); float s = un;
                  for (int j = 0; j < 15; ++j) { const float hv = state_pool[((size_t)bs * 15 + j) * PW + ch];
                      if (j >= 16 - wn) s += hv;
                      if (j >= 1) out[O_PS + ((size_t)bs * 15 + j - 1) * PW + ch] = hv; }
                  pb[sidx * 256 + ch] = s / (float)wn - un; } }
            LDS_SYNC();
            pool_matvec(pb, 8, MP + s0i, w_pool, ls_pool, MIX);
            LDS_SYNC();
        }
    }
}

constexpr int RT_STRIDE = 272, RT_TILE = 128 * RT_STRIDE;
__device__ __forceinline__ bf16x8 rt_frag(const LAS unsigned char* tile, int row, int kel) { return *(const LAS bf16x8*)(tile + row * RT_STRIDE + kel * 2); }
__device__ __forceinline__ void phase4(LAS unsigned char* lds, int G, const bf16_t* Q, const bf16_t* Kb, const bf16_t* VT, const bf16_t* SPREV, const bf16_t* GATE, bf16_t* MIX) {
    const int tid = threadIdx.x, lane = tid & 63, w = __builtin_amdgcn_readfirstlane(tid >> 6), wr = w >> 2, wc = w & 3, fr = lane & 15, fq = lane >> 4;
    LAS unsigned char* Tq = lds; LAS unsigned char* Tk = lds + RT_TILE; LAS unsigned char* Tv = lds + 2 * RT_TILE; LAS unsigned char* Ts = lds + 3 * RT_TILE;
    LAS float* red1 = (LAS float*)(lds + 4 * RT_TILE); LAS float* red2 = red1 + 512;
    for (int it = blockIdx.x; it < NBH * NCH; it += G) {
        const int bh = it / NCH, c = it % NCH, b = bh / NH, h = bh % NH;
        int lf = lane; asm volatile("" : "+v"(lf));
        const int fr = lf & 15, fq = lf >> 4;
        const float lg = lg2_gamma(h);
        const size_t row0 = (size_t)b * SEQ + c * 128;
#pragma unroll
        for (int i = 0; i < 4; ++i) {
            const int idx = tid + 512 * i, row = idx >> 4, ch = idx & 15;
            const u32x4 vq = *(const u32x4*)(Q + (row0 + row) * RW + h * HD + ch * 8);
            const u32x4 vk = *(const u32x4*)(Kb + (row0 + row) * RW + h * HD + ch * 8);
            const u32x4 vv = *(const u32x4*)(VT + ((size_t)bh * HD + row) * SEQ + c * 128 + ch * 8);
            const u32x4 vs = *(const u32x4*)(SPREV + (((size_t)bh * NCH + c) * HD + row) * HD + ch * 8);
            *(LAS u32x4*)(Tq + row * RT_STRIDE + ch * 16) = vq; *(LAS u32x4*)(Tk + row * RT_STRIDE + ch * 16) = vk;
            *(LAS u32x4*)(Tv + row * RT_STRIDE + ch * 16) = vv; *(LAS u32x4*)(Ts + row * RT_STRIDE + ch * 16) = vs;
        }
        BLOCK_SYNC();
        f32x4 sa[4][2], o[4][2];
#pragma unroll
        for (int mt = 0; mt < 4; ++mt)
#pragma unroll
            for (int nt = 0; nt < 2; ++nt) { sa[mt][nt] = (f32x4){0.f, 0.f, 0.f, 0.f}; o[mt][nt] = sa[mt][nt]; }
#pragma unroll 1
        for (int ks = 0; ks < 4; ++ks) {
            bf16x8 a[4], bk[2], bs[2];
#pragma unroll
            for (int mt = 0; mt < 4; ++mt) a[mt] = rt_frag(Tq, 64 * wr + 16 * mt + fr, ks * 32 + fq * 8);
#pragma unroll
            for (int nt = 0; nt < 2; ++nt) { bk[nt] = rt_frag(Tk, 32 * wc + 16 * nt + fr, ks * 32 + fq * 8); bs[nt] = rt_frag(Ts, 32 * wc + 16 * nt + fr, ks * 32 + fq * 8); }
#pragma unroll
            for (int mt = 0; mt < 4; ++mt)
#pragma unroll
                for (int nt = 0; nt < 2; ++nt) { sa[mt][nt] = mfma16(a[mt], bk[nt], sa[mt][nt]); o[mt][nt] = mfma16(a[mt], bs[nt], o[mt][nt]); }
        }
        LDS_SYNC();
#pragma unroll
        for (int mt = 0; mt < 4; ++mt)
#pragma unroll
            for (int j = 0; j < 4; ++j) {
                const int i = 64 * wr + 16 * mt + 4 * fq + j;
                const float qd = exp2f((float)(i + 1) * lg);
#pragma unroll
                for (int nt = 0; nt < 2; ++nt) {
                    const int jj = 32 * wc + 16 * nt + fr, dl = i - jj;
                    const float mv = dl >= 0 ? sa[mt][nt][j] * exp2f((float)dl * lg) : 0.f;
                    *(LAS bf16_t*)(Tk + i * RT_STRIDE + jj * 2) = (bf16_t)f2bf(mv);
                    o[mt][nt][j] *= qd;
                }
                asm volatile("" ::: "memory");
            }
        LDS_SYNC();
#pragma unroll 1
        for (int ks = 0; ks < 4; ++ks) {
            if (32 * ks > 64 * wr + 63) continue;
            bf16x8 a[4], bv[2];
#pragma unroll
            for (int mt = 0; mt < 4; ++mt) a[mt] = rt_frag(Tk, 64 * wr + 16 * mt + fr, ks * 32 + fq * 8);
#pragma unroll
            for (int nt = 0; nt < 2; ++nt) bv[nt] = rt_frag(Tv, 32 * wc + 16 * nt + fr, ks * 32 + fq * 8);
#pragma unroll
            for (int mt = 0; mt < 4; ++mt)
#pragma unroll
                for (int nt = 0; nt < 2; ++nt) o[mt][nt] = mfma16(a[mt], bv[nt], o[mt][nt]);
        }
#pragma unroll
        for (int mt = 0; mt < 4; ++mt)
#pragma unroll
            for (int j = 0; j < 4; ++j) {
                float s = o[mt][0][j] + o[mt][1][j];
                s += __shfl_xor(s, 1); s += __shfl_xor(s, 2); s += __shfl_xor(s, 4); s += __shfl_xor(s, 8);
                if (fr == 0) red1[(64 * wr + 16 * mt + 4 * fq + j) * 4 + wc] = s;
            }
        LDS_SYNC();
#pragma unroll
        for (int mt = 0; mt < 4; ++mt)
#pragma unroll
            for (int j = 0; j < 4; ++j) {
                const int i = 64 * wr + 16 * mt + 4 * fq + j;
                const f32x4 rs = *(const LAS f32x4*)(red1 + i * 4);
                const float mu = ((rs[0] + rs[1]) + (rs[2] + rs[3])) * (1.f / HD);
                o[mt][0][j] -= mu; o[mt][1][j] -= mu;
                float s = o[mt][0][j] * o[mt][0][j] + o[mt][1][j] * o[mt][1][j];
                s += __shfl_xor(s, 1); s += __shfl_xor(s, 2); s += __shfl_xor(s, 4); s += __shfl_xor(s, 8);
                if (fr == 0) red2[i * 4 + wc] = s;
            }
        LDS_SYNC();
#pragma unroll
        for (int mt = 0; mt < 4; ++mt)
#pragma unroll
            for (int j = 0; j < 4; ++j) {
                const int i = 64 * wr + 16 * mt + 4 * fq + j;
                const f32x4 rs = *(const LAS f32x4*)(red2 + i * 4);
                const float rstd = rsqrtf(((rs[0] + rs[1]) + (rs[2] + rs[3])) * (1.f / HD) + EPS);
#pragma unroll
                for (int nt = 0; nt < 2; ++nt) {
                    const int dv = 32 * wc + 16 * nt + fr;
                    const float gt = bf2f(GATE[(row0 + i) * RW + h * HD + dv]);
                    MIX[(row0 + i) * D + PW + h * HD + dv] = (bf16_t)f2bf(o[mt][nt][j] * rstd * gt);
                }
                asm volatile("" ::: "memory");
            }
        BLOCK_SYNC();
    }
}

__device__ __forceinline__ void phase_fix(int G, const float* AT, const float* AH, const float* BH, const float* cw, const float* cb, bf16_t* Gb) {
    const int total = 64 * 2 * DFF;
    for (int idx = blockIdx.x * 512 + threadIdx.x; idx < total; idx += G * 512) {
        const int pm = idx / (2 * DFF), rem = idx % (2 * DFF), rr = rem / DFF, c = rem % DFF;
        if ((pm & 7) == 0) continue;
        const float a_m1 = rr == 0 ? AT[((size_t)(pm - 1) * 2 + 1) * DFF + c] : AH[((size_t)pm * 2 + 0) * DFF + c];
        const float a_m2 = rr == 0 ? AT[((size_t)(pm - 1) * 2 + 0) * DFF + c] : AT[((size_t)(pm - 1) * 2 + 1) * DFF + c];
        const float a0 = AH[((size_t)pm * 2 + rr) * DFF + c], bb = BH[((size_t)pm * 2 + rr) * DFF + c];
        const float cv = cw[c] * a_m2 + cw[DFF + c] * a_m1 + cw[2 * DFF + c] * a0 + cb[c];
        Gb[((size_t)pm * 256 + rr) * DFF + c] = (bf16_t)f2bf(silu_f(cv) * bb);
    }
}

struct Args { const float* in[20]; float* out; unsigned char* ws; int ph_lo, ph_hi; };
__global__ void __launch_bounds__(512, 2) hymba_fwd(Args args) {
    extern __shared__ __attribute__((aligned(16))) unsigned char lds_raw[];
    LAS unsigned char* lds = (LAS unsigned char*)lds_raw;
    cg::grid_group grid = cg::this_grid();
    const int G = gridDim.x;
    unsigned char* ws = args.ws; float* out = args.out;
    const float *x_p = args.in[0], *x_s = args.in[1], *c_p = args.in[2], *c_s = args.in[3], *st_pool = args.in[4], *st_ret = args.in[5], *st_conv = args.in[6],
                *g_mix = args.in[7], *g_ffn = args.in[8], *w_ada = args.in[9], *b_ada = args.in[10], *w_in = args.in[11], *w_pool = args.in[12], *ls_pool = args.in[13],
                *w_out = args.in[14], *w_fi = args.in[15], *conv_w = args.in[16], *conv_b = args.in[17], *w_fo = args.in[18], *g_fin = args.in[19];
    float* mod = (float*)(ws + WS_MOD); float* rope = (float*)(ws + WS_ROPE); float* VS = (float*)(ws + WS_VS);
    bf16_t *WTin = (bf16_t*)(ws + WS_WIN), *WTout = (bf16_t*)(ws + WS_WOUT), *WTfi = (bf16_t*)(ws + WS_WFI), *WTfo = (bf16_t*)(ws + WS_WFO);
    float *AT = (float*)(ws + WS_HALO), *AH = AT + HALO_N, *BH = AH + HALO_N;
    bf16_t *RA = (bf16_t*)(ws + WS_RA), *RB = (bf16_t*)(ws + WS_RB), *Ub = (bf16_t*)(ws + WS_U), *GATE = (bf16_t*)(ws + WS_GATE), *Qb = (bf16_t*)(ws + WS_Q), *Kb = (bf16_t*)(ws + WS_K),
           *KT = (bf16_t*)(ws + WS_KT), *VT = (bf16_t*)(ws + WS_VT), *Gb = (bf16_t*)(ws + WS_G);
    bf16_t* SPREV = (bf16_t*)(out + O_YP);
    const int lo = args.ph_lo, hi = args.ph_hi;
#ifndef PH_MASK
#define PH_MASK 0x7ff
#endif
#define IN(k) (((PH_MASK >> (k)) & 1) && lo <= (k) && (k) < hi)
#define SEAM(k) do { if (IN(k) && IN((k) + 1)) { grid.sync(); } } while (0)

    if (IN(0)) phase0(lds, G, c_p, c_s, w_ada, b_ada, w_in, w_out, w_fi, w_fo, mod, rope, WTin, WTout, WTfi, WTfo);
    SEAM(0);
    if (IN(1)) norm_phase<0>(G, x_p, x_s, g_mix, mod, 0, 1, RA, nullptr);
    SEAM(1);
    if (IN(2)) {
        pg8::Gemm g{RA, WTin, MPAD, INC, D}; pg8::StaticOrder S; S.init(MPAD, INC, G, (int)blockIdx.x);
        EpiIn E{Ub, Qb, Kb, KT, VT, GATE, VS, rope, out};
        pg8::gemm_phase<EpiIn, pg8::StaticOrder, true, true>(lds, g, S, E);
    }
    SEAM(2);
    if (IN(3)) phase3(lds, G, Ub, Qb, Kb, KT, VT, GATE, VS, st_pool, st_ret, w_pool, ls_pool, SPREV, RB, out);
    SEAM(3);
    if (IN(4)) phase4(lds, G, Qb, Kb, VT, SPREV, GATE, RB);
    SEAM(4);
    if (IN(5)) {
        pg8::Gemm g{RB, WTout, MPAD, D, D}; pg8::StaticOrder S; S.init(MPAD, D, G, (int)blockIdx.x);
        EpiRes E{x_p, x_s, mod, 2, out + O_YP, 0};
        pg8::gemm_phase<EpiRes, pg8::StaticOrder, true, true>(lds, g, S, E);
    }
    SEAM(5);
    if (IN(6)) norm_phase<1>(G, nullptr, nullptr, g_ffn, mod, 3, 4, RA, out + O_YP);
    SEAM(6);
    if (IN(7)) {
        pg8::Gemm g{RA, WTfi, MPAD, NFF, D}; pg8::StaticOrder S; S.init(MPAD, NFF, G, (int)blockIdx.x);
        EpiFfn E{Gb, AT, AH, BH, conv_w, conv_b, st_conv, out, (LAS float*)(lds + LDS_X)};
        pg8::gemm_phase<EpiFfn, pg8::StaticOrder, true, true>(lds, g, S, E);
    }
    SEAM(7);
    if (IN(8)) phase_fix(G, AT, AH, BH, conv_w, conv_b, Gb);
    SEAM(8);
    if (IN(9)) {
        pg8::Gemm g{Gb, WTfo, MPAD, D, DFF}; pg8::StaticOrder S; S.init(MPAD, D, G, (int)blockIdx.x);
        EpiRes E{nullptr, nullptr, mod, 5, out + O_YP, 1};
        pg8::gemm_phase<EpiRes, pg8::StaticOrder, true, true>(lds, g, S, E);
    }
    SEAM(9);
    if (IN(10)) norm_phase<2>(G, nullptr, nullptr, g_fin, nullptr, 0, 0, nullptr, out + O_YP);
#undef IN
#undef SEAM
}

extern "C" void kernel_launch(void* const* d_in, const int* in_sizes, int n_in, void* d_out, int out_size, void* d_ws, size_t ws_size, hipStream_t stream) {
    static int grid = 0;
    if (grid == 0) {
        if (n_in != 20 || (size_t)out_size != O_END || ws_size < WS_END) { fprintf(stderr, "kernel_launch: unexpected problem shape (n_in %d, out %d, ws %zu)\n", n_in, out_size, ws_size); grid = -1; return; }
        int dev = 0, cus = 0, per_cu = 0;
        (void)hipGetDevice(&dev); (void)hipDeviceGetAttribute(&cus, hipDeviceAttributeMultiprocessorCount, dev);
        if (hipFuncSetAttribute((const void*)hymba_fwd, hipFuncAttributeMaxDynamicSharedMemorySize, LDS_BYTES) != hipSuccess) { fprintf(stderr, "kernel_launch: hipFuncSetAttribute failed\n"); grid = -1; return; }
        if (hipOccupancyMaxActiveBlocksPerMultiprocessor(&per_cu, (const void*)hymba_fwd, 512, LDS_BYTES) != hipSuccess || per_cu < 1) per_cu = 1;
        (void)hipGetLastError();
        grid = cus * per_cu;
        if (grid <= 0) grid = 256;
    }
    if (grid < 0) return;
    Args a{};
    for (int i = 0; i < 20; ++i) a.in[i] = (const float*)d_in[i];
    a.out = (float*)d_out; a.ws = (unsigned char*)d_ws;
#if MK_MULTI_LAUNCH
    for (int ph = 0; ph < NPHASE; ++ph) { a.ph_lo = ph; a.ph_hi = ph + 1; hipLaunchKernelGGL(hymba_fwd, dim3(grid), dim3(512), LDS_BYTES, stream, a); }
#else
    a.ph_lo = 0; a.ph_hi = NPHASE;
    void* kargs[] = {&a};
    hipError_t e = hipLaunchCooperativeKernel((const void*)hymba_fwd, dim3(grid), dim3(512), kargs, LDS_BYTES, stream);
    if (e != hipSuccess) fprintf(stderr, "kernel_launch: cooperative launch failed: %s (grid %d)\n", hipGetErrorString(e), grid);
#endif
}
```

```cpp
#include <hip/hip_runtime.h>
#include <hip/hip_cooperative_groups.h>
#include <cstdio>
#include <cstdint>
namespace cg = cooperative_groups;

#ifndef MK_MULTI_LAUNCH
#define MK_MULTI_LAUNCH 0
#endif
#ifndef MK_XCD_BARRIER
#define MK_XCD_BARRIER 1
#endif

namespace pg8 {
#define PG8_LAS __attribute__((address_space(3)))
typedef unsigned short bf16_t;
typedef short bf16x8 __attribute__((ext_vector_type(8)));
typedef float f32x4 __attribute__((ext_vector_type(4)));
typedef unsigned u32x4 __attribute__((ext_vector_type(4)));
constexpr int BM = 256, BK = 64, HALF = 128, HTB = HALF * BK * 2  , STAGE_BYTES = 8 * HTB, NXCD = 8, WGM = 8;

__host__ __device__ __forceinline__ int lds_byte(int r, int c) { const int st = (r >> 4) * 2 + (c >> 5), rr = r & 15, cc = c & 31, ob = rr * 64 + cc * 2; return st * 1024 + (ob ^ (((ob >> 9) & 1) << 5)); }
__host__ __device__ __forceinline__ void stage_rc(int b, int& R, int& C) { const int st = b / 1024, sb = b % 1024, swz = sb ^ (((sb >> 9) & 1) << 5); R = (st >> 1) * 16 + swz / 64; C = (st & 1) * 32 + (swz % 64) / 2; }
__host__ __device__ __forceinline__ int perm32(int rho) { const int n = rho >> 4, i = rho & 15; return 8 * (i >> 2) + 4 * n + (i & 3); }

struct Unit { int pm, pn; };
struct Gemm { const bf16_t* A; const bf16_t* Bt; int M, N, K; };

struct StaticOrder {
    int nM, nN, nwg, G, c;
    __host__ __device__ void init(int M, int N, int G_, int c_) { nM = M / BM; nN = N / BM; nwg = nM * nN; G = G_; c = c_; }
    __host__ __device__ bool next(int i, Unit& u) const {
        const long L = (long)i * G + c; if (L >= nwg) return false;
        int wgid = (int)L; { const int q = nwg / NXCD, r = nwg % NXCD, xcd = wgid % NXCD, off = wgid / NXCD; wgid = (xcd < r ? xcd * (q + 1) : r * (q + 1) + (xcd - r) * q) + off; }
        const int nig = WGM * nN, gid = wgid / nig, fm = gid * WGM, gsz = (nM - fm) < WGM ? (nM - fm) : WGM;
        u.pm = fm + ((wgid % nig) % gsz); u.pn = (wgid % nig) / gsz; return true;
    }
    __device__ __forceinline__ void a_ready(const Unit&) const {}
    __device__ __forceinline__ void done(const Unit&) const {}
};

__device__ __forceinline__ unsigned cvt_pk_bf16(float lo, float hi) { unsigned r; asm volatile("v_cvt_pk_bf16_f32 %0, %1, %2" : "=v"(r) : "v"(lo), "v"(hi)); return r; }
template <class Epi, class Sched, bool ALIGN_EPI = false, bool SP2 = false>
__device__ __forceinline__ void gemm_phase(PG8_LAS unsigned char* lds, const Gemm g, const Sched& S, const Epi& E) {
    const int tid = threadIdx.x, wid = __builtin_amdgcn_readfirstlane(tid >> 6), lane = tid & 63, wr = wid >> 2, wc = wid & 3, fr = lane & 15, fq = lane >> 4;
    const int K = g.K, nt = K / BK;
    unsigned voffA[2], voffB[2];
#pragma unroll
    for (int i = 0; i < 2; ++i) { int R, C; stage_rc(tid * 16 + i * 8192, R, C); const int Rb = Epi::PERM ? ((R & ~31) + perm32(R & 31)) : R;
        voffA[i] = (unsigned)(R * K + C) * 2u; voffB[i] = (unsigned)(Rb * K + C) * 2u; }
    const size_t kstep = (size_t)(BK * 2);
    const size_t hstep = (size_t)HALF * K * 2;
    const size_t tstep = 2 * hstep;
    const unsigned ldsw = (unsigned)wid * 1024u;
    const int aoff = lds_byte(wr * 64 + fr, fq * 8), boff = lds_byte(wc * 32 + fr, fq * 8);
#define PG8_SA(b, h) (((b) * 2 + (h)) * HTB)
#define PG8_SB(b, h) ((4 + (b) * 2 + (h)) * HTB)
#define PG8_STAGE(bufoff, gbase, voff) do { _Pragma("unroll") for (int _i = 0; _i < 2; ++_i) \
        __builtin_amdgcn_global_load_lds((const unsigned*)((const char*)(gbase) + (voff)[_i]), (PG8_LAS unsigned*)(lds + (bufoff) + ldsw + _i * 8192), 16, 0, 0); } while (0)
#define PG8_LDA(dst, b, h) do { _Pragma("unroll") for (int m = 0; m < 4; ++m) _Pragma("unroll") for (int k = 0; k < 2; ++k) dst[m][k] = *(const PG8_LAS bf16x8*)(lds + PG8_SA(b, h) + aoff + m * 2048 + k * 1024); } while (0)
#define PG8_LDB(dst, b, h) do { _Pragma("unroll") for (int n = 0; n < 2; ++n) _Pragma("unroll") for (int k = 0; k < 2; ++k) dst[n][k] = *(const PG8_LAS bf16x8*)(lds + PG8_SB(b, h) + boff + n * 2048 + k * 1024); } while (0)
#define PG8_MMA(ai, bj, At, Bt) do { __builtin_amdgcn_s_setprio(1); _Pragma("unroll") for (int m = 0; m < 4; ++m) _Pragma("unroll") for (int n = 0; n < 2; ++n) _Pragma("unroll") for (int k = 0; k < 2; ++k) \
        acc[ai][bj][m][n] = __builtin_amdgcn_mfma_f32_16x16x32_bf16(Bt[n][k], At[m][k], acc[ai][bj][m][n], 0, 0, 0); __builtin_amdgcn_s_setprio(0); } while (0)
#define PG8_WAIT_V(n) asm volatile("s_waitcnt vmcnt(" #n ")" ::: "memory")
#define PG8_WAIT_L(n) asm volatile("s_waitcnt lgkmcnt(" #n ")" ::: "memory")
#define PG8_BAR __builtin_amdgcn_s_barrier()
#define PG8_SCHED __builtin_amdgcn_sched_barrier(0)
    Unit cur, nxt; int ui = 0;
    if (!S.next(0, cur)) return;
    f32x4 acc[2][2][4][2];
#pragma unroll
    for (int a = 0; a < 2; ++a)
#pragma unroll
        for (int b = 0; b < 2; ++b)
#pragma unroll
            for (int m = 0; m < 4; ++m)
#pragma unroll
                for (int n = 0; n < 2; ++n) acc[a][b][m][n] = (f32x4){0.f, 0.f, 0.f, 0.f};
    bf16x8 At[4][2], B0[2][2], B1[2][2];
    const char* cA = (const char*)g.A + (size_t)cur.pm * tstep; const char* cB = (const char*)g.Bt + (size_t)cur.pn * tstep;
    S.a_ready(cur);
    if constexpr (SP2) {
        PG8_STAGE(PG8_SB(0, 0), cB, voffB); PG8_STAGE(PG8_SB(0, 1), cB + hstep, voffB); PG8_STAGE(PG8_SA(0, 0), cA, voffA); PG8_STAGE(PG8_SA(0, 1), cA + hstep, voffA);
        if (wr == 1) PG8_BAR;
        PG8_WAIT_V(2); PG8_BAR;
        PG8_STAGE(PG8_SB(1, 0), cB + kstep, voffB); PG8_STAGE(PG8_SA(1, 0), cA + kstep, voffA); PG8_STAGE(PG8_SB(1, 1), cB + hstep + kstep, voffB);
        PG8_WAIT_V(6); PG8_BAR;
    } else {
        PG8_STAGE(PG8_SB(0, 0), cB, voffB); PG8_STAGE(PG8_SA(0, 0), cA, voffA); PG8_STAGE(PG8_SB(0, 1), cB + hstep, voffB); PG8_STAGE(PG8_SA(0, 1), cA + hstep, voffA);
        if (wr == 1) PG8_BAR;
        PG8_WAIT_V(4); PG8_BAR;
        PG8_STAGE(PG8_SB(1, 0), cB + kstep, voffB); PG8_STAGE(PG8_SA(1, 0), cA + kstep, voffA); PG8_STAGE(PG8_SB(1, 1), cB + hstep + kstep, voffB);
        PG8_WAIT_V(6); PG8_BAR;
    }
    for (;;) {
        const bool has_next = S.next(ui + 1, nxt);
        const char* nA = has_next ? (const char*)g.A + (size_t)nxt.pm * tstep : cA; const char* nB = has_next ? (const char*)g.Bt + (size_t)nxt.pn * tstep : cB;
        for (int t = 0; t < nt; t += 2) {
            const bool last = (t == nt - 2);
            const char* a1 = cA + (size_t)(t + 1) * kstep;
            const char* a2 = last ? nA : cA + (size_t)(t + 2) * kstep; const char* b2 = last ? nB : cB + (size_t)(t + 2) * kstep;
            const char* a3 = a2 + kstep; const char* b3 = b2 + kstep;
            if (last && has_next) S.a_ready(nxt);
            if constexpr (SP2) {
            PG8_LDB(B0, 0, 0); PG8_LDB(B1, 0, 1); PG8_SCHED; PG8_LDA(At, 0, 0); PG8_STAGE(PG8_SA(1, 1), a1 + hstep, voffA);
            PG8_WAIT_V(8); PG8_WAIT_L(0); PG8_BAR; PG8_MMA(0, 0, At, B0); PG8_MMA(0, 1, At, B1); PG8_BAR; PG8_SCHED;
            PG8_LDA(At, 0, 1); PG8_STAGE(PG8_SB(0, 0), b2, voffB); PG8_STAGE(PG8_SB(0, 1), b2 + hstep, voffB); PG8_STAGE(PG8_SA(0, 0), a2, voffA);
            PG8_WAIT_V(8); PG8_WAIT_L(0); PG8_BAR; PG8_MMA(1, 0, At, B0); PG8_MMA(1, 1, At, B1); PG8_BAR; PG8_SCHED;
            PG8_LDB(B0, 1, 0); PG8_LDB(B1, 1, 1); PG8_SCHED; PG8_LDA(At, 1, 0); PG8_STAGE(PG8_SA(0, 1), a2 + hstep, voffA);
            PG8_WAIT_V(8); PG8_WAIT_L(0); PG8_BAR; PG8_MMA(0, 0, At, B0); PG8_MMA(0, 1, At, B1); PG8_BAR; PG8_SCHED;
            PG8_LDA(At, 1, 1); PG8_STAGE(PG8_SB(1, 0), b3, voffB); PG8_STAGE(PG8_SB(1, 1), b3 + hstep, voffB); PG8_STAGE(PG8_SA(1, 0), a3, voffA);
            PG8_WAIT_V(8); PG8_WAIT_L(0); PG8_BAR; PG8_MMA(1, 0, At, B0); PG8_MMA(1, 1, At, B1); PG8_BAR; PG8_SCHED;
            } else {
            PG8_LDB(B0, 0, 0); PG8_SCHED; PG8_LDA(At, 0, 0); PG8_STAGE(PG8_SA(1, 1), a1 + hstep, voffA);
            PG8_WAIT_L(8); PG8_BAR; PG8_WAIT_L(0); PG8_MMA(0, 0, At, B0); PG8_BAR; PG8_SCHED;
            PG8_LDB(B1, 0, 1); PG8_STAGE(PG8_SB(0, 0), b2, voffB);
            PG8_BAR; PG8_WAIT_L(0); PG8_MMA(0, 1, At, B1); PG8_BAR;
            PG8_LDA(At, 0, 1); PG8_STAGE(PG8_SA(0, 0), a2, voffA);
            PG8_BAR; PG8_WAIT_L(0); PG8_MMA(1, 0, At, B0); PG8_BAR; PG8_SCHED;
            PG8_STAGE(PG8_SB(0, 1), b2 + hstep, voffB);
            PG8_WAIT_V(6); PG8_BAR; PG8_MMA(1, 1, At, B1); PG8_BAR;
            PG8_LDB(B0, 1, 0); PG8_SCHED; PG8_LDA(At, 1, 0); PG8_STAGE(PG8_SA(0, 1), a2 + hstep, voffA);
            PG8_WAIT_L(8); PG8_BAR; PG8_WAIT_L(0); PG8_MMA(0, 0, At, B0); PG8_BAR; PG8_SCHED;
            PG8_LDB(B1, 1, 1); PG8_STAGE(PG8_SB(1, 0), b3, voffB);
            PG8_BAR; PG8_WAIT_L(0); PG8_MMA(0, 1, At, B1); PG8_BAR;
            PG8_LDA(At, 1, 1); PG8_STAGE(PG8_SA(1, 0), a3, voffA);
            PG8_BAR; PG8_WAIT_L(0); PG8_MMA(1, 0, At, B0); PG8_BAR; PG8_SCHED;
            PG8_STAGE(PG8_SB(1, 1), b3 + hstep, voffB);
            PG8_WAIT_V(6); PG8_BAR; PG8_MMA(1, 1, At, B1); PG8_BAR;
            }
        }
        if constexpr (ALIGN_EPI) { if (wr == 0) PG8_BAR; }
        if constexpr (!Epi::AFTER_DRAIN) { E(acc, cur, wr, wc, fr, fq); S.done(cur); }
        if (!has_next) break;
#pragma unroll
        for (int a = 0; a < 2; ++a)
#pragma unroll
            for (int b = 0; b < 2; ++b)
#pragma unroll
                for (int m = 0; m < 4; ++m)
#pragma unroll
                    for (int n = 0; n < 2; ++n) acc[a][b][m][n] = (f32x4){0.f, 0.f, 0.f, 0.f};
        cur = nxt; cA = nA; cB = nB; ++ui;
        if constexpr (ALIGN_EPI) { if (wr == 1) PG8_BAR; }
    }
    PG8_WAIT_V(0);
    if constexpr (!ALIGN_EPI) { if (wr == 0) PG8_BAR; }
    PG8_BAR;
    if constexpr (Epi::AFTER_DRAIN) { E.fused(acc, cur, wr, wc, fr, fq, lds, wid, lane); S.done(cur); }
#undef PG8_SA
#undef PG8_SB
#undef PG8_STAGE
#undef PG8_LDA
#undef PG8_LDB
#undef PG8_MMA
#undef PG8_WAIT_V
#undef PG8_WAIT_L
#undef PG8_BAR
#undef PG8_SCHED
}
}

#define LAS __attribute__((address_space(3)))
typedef unsigned short bf16_t;
typedef float f32x4 __attribute__((ext_vector_type(4)));
typedef short bf16x8 __attribute__((ext_vector_type(8)));
typedef unsigned u32x4 __attribute__((ext_vector_type(4)));
typedef unsigned u32x2 __attribute__((ext_vector_type(2)));

constexpr int D = 1024, BP = 8, SEQ = 2048, MP = BP * SEQ, BS = 128, MR = MP + BS, MPAD = 16640;
constexpr int PW = 256, RW = 768, NH = 6, HD = 128, INC = 3328, DFF = 2816, NFF = 5632, NMODC = 6 * D;
constexpr int NCH = SEQ / 128, NBH = BP * NH;
constexpr float EPS = 1e-6f;
constexpr size_t O_YP = 0, O_YS = 16777216, O_PP = 16908288, O_RP = 16939008, O_CP = 17725440, O_PS = 17770496, O_RS = 18262016, O_CS = 30844928, O_END = 31565824;
constexpr size_t MiB = 1u << 20;
constexpr size_t WS_CTL = 0, WS_MOD = 1 * MiB, WS_ROPE = 5 * MiB, WS_VS = 7 * MiB, WS_WIN = 8 * MiB, WS_WOUT = 15 * MiB, WS_WFI = 17 * MiB, WS_WFO = 28 * MiB,
                 WS_HALO = 34 * MiB, WS_RA = 40 * MiB, WS_RB = 73 * MiB, WS_U = 106 * MiB, WS_GATE = 115 * MiB, WS_Q = 140 * MiB, WS_K = 165 * MiB,
                 WS_KT = 190 * MiB, WS_VT = 214 * MiB, WS_G = 140 * MiB, WS_END = 238 * MiB;
constexpr size_t HALO_N = (size_t)65 * 2 * DFF;
constexpr int LDS_BYTES = 147456;
constexpr int LDS_X = 131072;
constexpr int NPHASE = 11;

__device__ __forceinline__ float bf2f(unsigned v) { return __uint_as_float(v << 16); }
__device__ __forceinline__ unsigned f2bf(float f) { unsigned u = __float_as_uint(f); return (u + 0x7fffu + ((u >> 16) & 1u)) >> 16; }
__device__ __forceinline__ unsigned pk2(float lo, float hi) { return pg8::cvt_pk_bf16(lo, hi); }
__device__ __forceinline__ float silu_f(float x) { return x / (1.f + __expf(-x)); }
__device__ __forceinline__ float wave_sum(float v) {
#pragma unroll
    for (int o = 1; o < 64; o <<= 1) v += __shfl_xor(v, o);
    return v;
}
__device__ __forceinline__ float lg2_gamma(int h) { return log2f(1.0f - exp2f(-5.0f - (float)h)); }
__device__ __forceinline__ f32x4 mfma16(bf16x8 a, bf16x8 b, f32x4 c) { return __builtin_amdgcn_mfma_f32_16x16x32_bf16(a, b, c, 0, 0, 0); }
#define BLOCK_SYNC() do { asm volatile("s_waitcnt vmcnt(0) lgkmcnt(0)" ::: "memory"); __builtin_amdgcn_s_barrier(); asm volatile("" ::: "memory"); } while (0)
#define LDS_SYNC() do { asm volatile("s_waitcnt lgkmcnt(0)" ::: "memory"); __builtin_amdgcn_s_barrier(); asm volatile("" ::: "memory"); } while (0)

template <int MAP> __device__ __forceinline__ int wrow_map(int c) {
    if (MAP == 1) return (c & ~127) | (32 * ((c & 63) >> 4) + 16 * ((c & 127) >> 6) + (c & 15));
    if (MAP == 2) { const int a = c < DFF ? c : c - DFF; return 256 * (a >> 7) + (c < DFF ? 0 : 128) + (a & 127); }
    return c;
}
template <int MAP> __device__ __forceinline__ void p0_transpose_item(const float* __restrict__ W, int K, int N, bf16_t* __restrict__ WT, LAS float* scr, int item, int lane) {
    const int nblk = N / 32, kb = item / nblk, nb = item % nblk, k0 = 64 * kb, n0 = 32 * nb;
#pragma unroll 8
    for (int i = 0; i < 32; ++i) { const int kk = 2 * i + (lane >> 5); scr[kk * 33 + (lane & 31)] = W[(size_t)(k0 + kk) * N + n0 + (lane & 31)]; }
    asm volatile("s_waitcnt lgkmcnt(0)" ::: "memory");
    const int c = lane & 7;
#pragma unroll
    for (int j = 0; j < 4; ++j) { const int n = (lane >> 3) + 8 * j; const LAS float* s = scr + (8 * c) * 33 + n;
        u32x4 o; o.x = pk2(s[0 * 33], s[1 * 33]); o.y = pk2(s[2 * 33], s[3 * 33]); o.z = pk2(s[4 * 33], s[5 * 33]); o.w = pk2(s[6 * 33], s[7 * 33]);
        *(u32x4*)(WT + (size_t)wrow_map<MAP>(n0 + n) * K + k0 + 8 * c) = o; }
    asm volatile("s_waitcnt lgkmcnt(0)" ::: "memory");
}

__device__ __forceinline__ void phase0(LAS unsigned char* lds, int G, const float* c_p, const float* c_s, const float* w_ada, const float* b_ada,
                                       const float* w_in, const float* w_out, const float* w_fi, const float* w_fo,
                                       float* mod, float* rope, bf16_t* WTin, bf16_t* WTout, bf16_t* WTfi, bf16_t* WTfo) {
    const int tid = threadIdx.x, lane = tid & 63, w = __builtin_amdgcn_readfirstlane(tid >> 6), fr = lane & 15, fq = lane >> 4;
    LAS float* red = (LAS float*)lds;
    for (int it = blockIdx.x; it < NMODC / 32; it += G) {
        const int n0 = it * 32;
        f32x4 acc[9][2];
#pragma unroll
        for (int mt = 0; mt < 9; ++mt) { acc[mt][0] = (f32x4){0.f, 0.f, 0.f, 0.f}; acc[mt][1] = (f32x4){0.f, 0.f, 0.f, 0.f}; }
#pragma unroll 1
        for (int ks = 0; ks < 4; ++ks) {
            const int k0 = 128 * w + 32 * ks + fq * 8;
            bf16x8 bfr[2];
#pragma unroll
            for (int nt = 0; nt < 2; ++nt) {
                const float* wp = w_ada + (size_t)k0 * NMODC + n0 + 16 * nt + fr;
                float t[8];
#pragma unroll
                for (int j = 0; j < 8; ++j) t[j] = wp[(size_t)j * NMODC];
                u32x4 pk; pk.x = pk2(t[0], t[1]); pk.y = pk2(t[2], t[3]); pk.z = pk2(t[4], t[5]); pk.w = pk2(t[6], t[7]);
                bfr[nt] = __builtin_bit_cast(bf16x8, pk);
            }
#pragma unroll
            for (int mt = 0; mt < 9; ++mt) {
                const int row = 16 * mt + fr;
                u32x4 pk = (u32x4){0u, 0u, 0u, 0u};
                if (row < BP + BS) {
                    const float* cp = (row < BP ? c_p + (size_t)row * D : c_s + (size_t)(row - BP) * D) + k0;
                    const f32x4 a0 = *(const f32x4*)cp, a1 = *(const f32x4*)(cp + 4);
                    pk.x = pk2(silu_f(a0[0]), silu_f(a0[1])); pk.y = pk2(silu_f(a0[2]), silu_f(a0[3]));
                    pk.z = pk2(silu_f(a1[0]), silu_f(a1[1])); pk.w = pk2(silu_f(a1[2]), silu_f(a1[3]));
                }
                const bf16x8 afr = __builtin_bit_cast(bf16x8, pk);
                acc[mt][0] = mfma16(afr, bfr[0], acc[mt][0]);
                acc[mt][1] = mfma16(afr, bfr[1], acc[mt][1]);
            }
        }
#pragma unroll 1
        for (int r = 0; r < 8; ++r) {
            if (w == r) {
#pragma unroll
                for (int mt = 0; mt < 9; ++mt)
#pragma unroll
                    for (int nt = 0; nt < 2; ++nt)
#pragma unroll
                        for (int j = 0; j < 4; ++j) { const int idx = (16 * mt + 4 * fq + j) * 32 + 16 * nt + fr; red[idx] = (r == 0 ? 0.f : red[idx]) + acc[mt][nt][j]; }
            }
            LDS_SYNC();
        }
        for (int idx = tid; idx < (BP + BS) * 32; idx += 512) { const int row = idx >> 5, c = idx & 31; mod[(size_t)row * NMODC + n0 + c] = red[idx] + b_ada[n0 + c]; }
        LDS_SYNC();
    }
    {
        LAS float* scr = (LAS float*)(lds + w * 16384);
        const int gw = blockIdx.x * 8 + w, NGW = G * 8;
        constexpr int I_IN = (D / 64) * (INC / 32), I_OUT = (D / 64) * (D / 32), I_FI = (D / 64) * (NFF / 32), I_FO = (DFF / 64) * (D / 32);
        constexpr int NITEMS = I_IN + I_OUT + I_FI + I_FO;
        for (int it = NITEMS - 1 - gw; it >= 0; it -= NGW) {
            int r = it;
            if (r < I_IN) { p0_transpose_item<1>(w_in, D, INC, WTin, scr, r, lane); continue; } r -= I_IN;
            if (r < I_OUT) { p0_transpose_item<0>(w_out, D, D, WTout, scr, r, lane); continue; } r -= I_OUT;
            if (r < I_FI) { p0_transpose_item<2>(w_fi, D, NFF, WTfi, scr, r, lane); continue; } r -= I_FI;
            p0_transpose_item<0>(w_fo, DFF, D, WTfo, scr, r, lane);
        }
    }
    for (int idx = blockIdx.x * 512 + tid; idx < (SEQ + 1) * 64; idx += G * 512) {
        const int ps = idx >> 6, i = idx & 63;
        const double pos = ps == SEQ ? 16384.0 : (double)ps;
        const double inv = exp(-(double)i * (9.210340371976184 / 64.0));
        double s, c; sincos(pos * inv, &s, &c);
        rope[(size_t)ps * 128 + i] = (float)c; rope[(size_t)ps * 128 + 64 + i] = (float)s;
    }
}

template <int MODE> __device__ __forceinline__ void norm_phase(int G, const float* xp, const float* xs, const float* gvec, const float* mod, int sh_i, int sc_i, bf16_t* H, float* outy) {
    const int tid = threadIdx.x, lane = tid & 63, w = tid >> 6;
    const int gw = blockIdx.x * 8 + w, NGW = G * 8;
    const int nrows = MODE == 2 ? MR : MPAD;
    for (int r = gw; r < nrows; r += NGW) {
        if (MODE != 2 && r >= MR) {
            u32x2* o = (u32x2*)(H + (size_t)r * D) + lane;
#pragma unroll
            for (int j = 0; j < 4; ++j) o[64 * j] = (u32x2){0u, 0u};
            continue;
        }
        const float* src = MODE == 0 ? (r < MP ? xp + (size_t)r * D : xs + (size_t)(r - MP) * D) : outy + (size_t)r * D;
        const f32x4* xr = (const f32x4*)src + lane;
        f32x4 v[4]; float ss = 0.f;
#pragma unroll
        for (int j = 0; j < 4; ++j) { v[j] = xr[64 * j]; ss += (v[j][0] * v[j][0] + v[j][1] * v[j][1]) + (v[j][2] * v[j][2] + v[j][3] * v[j][3]); }
        const float rstd = rsqrtf(wave_sum(ss) * (1.f / D) + EPS);
        if (MODE == 2) {
            f32x4* o = (f32x4*)(outy + (size_t)r * D) + lane;
#pragma unroll
            for (int j = 0; j < 4; ++j) { const f32x4 g4 = ((const f32x4*)gvec)[lane + 64 * j]; o[64 * j] = v[j] * rstd * g4; }
        } else {
            const int nb = r < MP ? (r >> 11) : BP + (r - MP);
            const f32x4* scp = (const f32x4*)(mod + (size_t)nb * NMODC + sc_i * D) + lane;
            const f32x4* shp = (const f32x4*)(mod + (size_t)nb * NMODC + sh_i * D) + lane;
            u32x2* o = (u32x2*)(H + (size_t)r * D) + lane;
#pragma unroll
            for (int j = 0; j < 4; ++j) { const f32x4 g4 = ((const f32x4*)gvec)[lane + 64 * j], sc = scp[64 * j], sh = shp[64 * j];
                const f32x4 y = v[j] * rstd * g4 * (sc + 1.0f) + sh;
                o[64 * j] = (u32x2){pk2(y[0], y[1]), pk2(y[2], y[3])}; }
        }
    }
}

struct EpiIn {
    static constexpr bool PERM = false, AFTER_DRAIN = false;
    bf16_t *U, *Q, *Kb, *KT, *VT, *GATE; float* VS; const float* rope; float* out;
    __device__ __forceinline__ void operator()(const f32x4 (&acc)[2][2][4][2], const pg8::Unit& u, int wr, int wc, int fr, int fq) const {
        const int p0 = 16 * wc + 4 * fq;
#pragma unroll
        for (int bj = 0; bj < 2; ++bj) {
            const int blk = 2 * u.pn + bj;
            const int region = blk < 2 ? 0 : 1 + (blk - 2) / NH, h = blk < 2 ? blk : (blk - 2) % NH;
            const float lg = lg2_gamma(h);
#pragma unroll
            for (int ai = 0; ai < 2; ++ai)
#pragma unroll
                for (int m = 0; m < 4; ++m) {
                    const int r = u.pm * 256 + ai * 128 + wr * 64 + m * 16 + fr;
                    if (r >= MR) continue;
                    const bool samp = r >= MP; const int b = r >> 11, t = r & (SEQ - 1), bs = r - MP;
                    const f32x4 v0 = acc[ai][bj][m][0], v1 = acc[ai][bj][m][1];
                    if (region == 0) {
                        const int c0 = 128 * h + p0;
                        *(u32x2*)(U + (size_t)r * PW + c0) = (u32x2){pk2(v0[0], v0[1]), pk2(v0[2], v0[3])};
                        *(u32x2*)(U + (size_t)r * PW + c0 + 64) = (u32x2){pk2(v1[0], v1[1]), pk2(v1[2], v1[3])};
                        if (samp) { float* o = out + O_PS + ((size_t)bs * 15 + 14) * PW + c0; *(f32x4*)o = v0; *(f32x4*)(o + 64) = v1; }
                        else if (t >= SEQ - 15) { float* o = out + O_PP + ((size_t)b * 15 + (t - (SEQ - 15))) * PW + c0; *(f32x4*)o = v0; *(f32x4*)(o + 64) = v1; }
                    } else if (region == 1 || region == 2) {
                        const float* cs = rope + (size_t)(samp ? SEQ : t) * 128 + p0;
                        const f32x4 c4 = *(const f32x4*)cs, s4 = *(const f32x4*)(cs + 64);
                        f32x4 o1 = v0 * c4 - v1 * s4, o2 = v0 * s4 + v1 * c4;
                        if (region == 2) { o1 = o1 * 0.08838834764831845f; o2 = o2 * 0.08838834764831845f; }
                        bf16_t* dst = (region == 1 ? Q : Kb) + (size_t)r * RW + h * HD + p0;
                        *(u32x2*)dst = (u32x2){pk2(o1[0], o1[1]), pk2(o1[2], o1[3])};
                        *(u32x2*)(dst + 64) = (u32x2){pk2(o2[0], o2[1]), pk2(o2[2], o2[3])};
                        if (region == 2 && !samp) {
                            const float kd = exp2f((float)(127 - (t & 127)) * lg);
                            bf16_t* kt = KT + ((size_t)(b * NH + h) * HD + p0) * SEQ + t;
#pragma unroll
                            for (int e = 0; e < 4; ++e) { kt[(size_t)e * SEQ] = (bf16_t)f2bf(o1[e] * kd); kt[(size_t)(64 + e) * SEQ] = (bf16_t)f2bf(o2[e] * kd); }
                        }
                    } else if (region == 3) {
                        if (samp) { float* o = VS + (size_t)bs * RW + h * HD + p0; *(f32x4*)o = v0; *(f32x4*)(o + 64) = v1; }
                        else {
                            bf16_t* vt = VT + ((size_t)(b * NH + h) * HD + p0) * SEQ + t;
#pragma unroll
                            for (int e = 0; e < 4; ++e) { vt[(size_t)e * SEQ] = (bf16_t)f2bf(v0[e]); vt[(size_t)(64 + e) * SEQ] = (bf16_t)f2bf(v1[e]); }
                        }
                    } else {
                        bf16_t* dst = GATE + (size_t)r * RW + h * HD + p0;
                        *(u32x2*)dst = (u32x2){pk2(silu_f(v0[0]), silu_f(v0[1])), pk2(silu_f(v0[2]), silu_f(v0[3]))};
                        *(u32x2*)(dst + 64) = (u32x2){pk2(silu_f(v1[0]), silu_f(v1[1])), pk2(silu_f(v1[2]), silu_f(v1[3]))};
                    }
                }
        }
    }
};
struct EpiRes {
    static constexpr bool PERM = false, AFTER_DRAIN = false;
    const float *xp, *xs; const float* mod; int gate_i; float* outy; int from_out;
    __device__ __forceinline__ void operator()(const f32x4 (&acc)[2][2][4][2], const pg8::Unit& u, int wr, int wc, int fr, int fq) const {
#pragma unroll
        for (int ai = 0; ai < 2; ++ai)
#pragma unroll
            for (int m = 0; m < 4; ++m) {
                const int r = u.pm * 256 + ai * 128 + wr * 64 + m * 16 + fr;
                if (r >= MR) continue;
                const int nb = r < MP ? (r >> 11) : BP + (r - MP);
                const float* base = from_out ? outy + (size_t)r * D : (r < MP ? xp + (size_t)r * D : xs + (size_t)(r - MP) * D);
                const float* gp = mod + (size_t)nb * NMODC + gate_i * D;
#pragma unroll
                for (int bj = 0; bj < 2; ++bj)
#pragma unroll
                    for (int n = 0; n < 2; ++n) {
                        const int c = u.pn * 256 + bj * 128 + wc * 32 + n * 16 + fq * 4;
                        const f32x4 bv = *(const f32x4*)(base + c), gv = *(const f32x4*)(gp + c);
                        *(f32x4*)(outy + (size_t)r * D + c) = bv + gv * acc[ai][bj][m][n];
                    }
            }
    }
};
struct EpiFfn {
    static constexpr bool PERM = false, AFTER_DRAIN = false;
    bf16_t* Gb; float *AT, *AH, *BH; const float *cw, *cb, *sconv; float* out; LAS float* tail;
    __device__ __forceinline__ void operator()(const f32x4 (&acc)[2][2][4][2], const pg8::Unit& u, int wr, int wc, int fr, int fq) const {
        asm volatile("" : "+v"(fr), "+v"(fq));
        const int lane = fq * 16 + fr, pm = u.pm;
        int ca[2];
#pragma unroll
        for (int n = 0; n < 2; ++n) ca[n] = 128 * u.pn + 32 * wc + 16 * n + 4 * fq;
        if (pm == MP / 256) {
#pragma unroll
            for (int m = 0; m < 4; ++m)
#pragma unroll
                for (int n = 0; n < 2; ++n) {
                    const int bs = wr * 64 + m * 16 + fr;
                    const f32x4 a = acc[0][0][m][n], bb = acc[0][1][m][n];
                    const f32x4 s0 = *(const f32x4*)(sconv + ((size_t)bs * 2 + 0) * DFF + ca[n]), s1 = *(const f32x4*)(sconv + ((size_t)bs * 2 + 1) * DFF + ca[n]);
                    const f32x4 w0 = *(const f32x4*)(cw + ca[n]), w1 = *(const f32x4*)(cw + DFF + ca[n]), w2 = *(const f32x4*)(cw + 2 * DFF + ca[n]), cbv = *(const f32x4*)(cb + ca[n]);
                    const f32x4 cv = w0 * s0 + w1 * s1 + w2 * a + cbv;
                    f32x4 g;
#pragma unroll
                    for (int e = 0; e < 4; ++e) g[e] = silu_f(cv[e]) * bb[e];
                    *(u32x2*)(Gb + (size_t)(MP + bs) * DFF + ca[n]) = (u32x2){pk2(g[0], g[1]), pk2(g[2], g[3])};
                    *(f32x4*)(out + O_CS + ((size_t)bs * 2 + 0) * DFF + ca[n]) = s1;
                    *(f32x4*)(out + O_CS + ((size_t)bs * 2 + 1) * DFF + ca[n]) = a;
                }
            return;
        }
        if (fr >= 14) {
#pragma unroll
            for (int ai = 0; ai < 2; ++ai)
#pragma unroll
                for (int n = 0; n < 2; ++n) {
                    const f32x4 v = acc[ai][0][3][n];
                    *(LAS f32x4*)(tail + (((ai * 2 + wr) * 4 + wc) * 2 + (fr - 14)) * 32 + 16 * n + 4 * fq) = v;
                    if (ai == 1 && wr == 1) {
                        *(f32x4*)(AT + ((size_t)pm * 2 + (fr - 14)) * DFF + ca[n]) = v;
                        if ((pm & 7) == 7) *(f32x4*)(out + O_CP + ((size_t)(pm >> 3) * 2 + (fr - 14)) * DFF + ca[n]) = v;
                    }
                }
        }
        LDS_SYNC();
#pragma unroll
        for (int n = 0; n < 2; ++n) {
            const int can = 128 * u.pn + 32 * wc + 16 * n + 4 * fq;
            const f32x4 w0 = *(const f32x4*)(cw + can), w1 = *(const f32x4*)(cw + DFF + can), w2 = *(const f32x4*)(cw + 2 * DFF + can), cbv = *(const f32x4*)(cb + can);
#pragma unroll
            for (int ai = 0; ai < 2; ++ai) {
                const int s = ai * 2 + wr;
                f32x4 prev = (f32x4){0.f, 0.f, 0.f, 0.f};
                if (s > 0 && fr >= 14) prev = *(const LAS f32x4*)(tail + ((((s - 1) * 4) + wc) * 2 + (fr - 14)) * 32 + 16 * n + 4 * fq);
#pragma unroll
                for (int m = 0; m < 4; ++m) {
                    const int r = pm * 256 + ai * 128 + wr * 64 + m * 16 + fr;
                    const bool top = (s == 0 && m == 0 && fr < 2 && (pm & 7) != 0);
                    const f32x4 cur = acc[ai][0][m][n], bb = acc[ai][1][m][n];
                    f32x4 g;
#pragma unroll
                    for (int e = 0; e < 4; ++e) {
                        const float c1 = __shfl(cur[e], lane - 1), c2 = __shfl(cur[e], lane - 2), q1 = __shfl(prev[e], lane + 15), q2 = __shfl(prev[e], lane + 14);
                        const float a1 = fr >= 1 ? c1 : q1, a2 = fr >= 2 ? c2 : q2;
                        g[e] = silu_f(w0[e] * a2 + w1[e] * a1 + w2[e] * cur[e] + cbv[e]) * bb[e];
                    }
                    if (top) { *(f32x4*)(AH + ((size_t)pm * 2 + fr) * DFF + can) = cur; *(f32x4*)(BH + ((size_t)pm * 2 + fr) * DFF + can) = bb; }
                    else *(u32x2*)(Gb + (size_t)r * DFF + can) = (u32x2){pk2(g[0], g[1]), pk2(g[2], g[3])};
                    prev = cur;
                    asm volatile("" ::: "memory");
                }
            }
        }
    }
};

__device__ __forceinline__ void pool_matvec(LAS float* pbuf, int ntok, int row0, const float* w_pool, const float* ls_pool, bf16_t* MIX) {
    const int tid = threadIdx.x, d = tid & 63, g = (tid >> 6) & 3, half = tid >> 8;
    float wc[64];
#pragma unroll
    for (int c = 0; c < 64; ++c) wc[c] = w_pool[(size_t)(g * 64 + c) * 64 + d];
    const float ls = ls_pool[g * 64 + d];
    const int per = ntok >> 1;
    for (int tt = half * per; tt < (half + 1) * per; ++tt) {
        const LAS f32x4* pp = (const LAS f32x4*)(pbuf + tt * 256 + g * 64);
        float y = 0.f;
#pragma unroll
        for (int c4 = 0; c4 < 16; ++c4) { const f32x4 p4 = pp[c4]; y += p4[0] * wc[4 * c4] + p4[1] * wc[4 * c4 + 1] + p4[2] * wc[4 * c4 + 2] + p4[3] * wc[4 * c4 + 3]; }
        MIX[(size_t)(row0 + tt) * D + g * 64 + d] = (bf16_t)f2bf(y * ls);
    }
}

__device__ __forceinline__ void phase3(LAS unsigned char* lds, int G, const bf16_t* U, const bf16_t* Q, const bf16_t* Kb, const bf16_t* KT, const bf16_t* VT, const bf16_t* GATE,
                                       const float* VS, const float* state_pool, const float* state_ret, const float* w_pool, const float* ls_pool,
                                       bf16_t* SPREV, bf16_t* MIX, float* out) {
    const int tid = threadIdx.x, lane = tid & 63, w = __builtin_amdgcn_readfirstlane(tid >> 6), fr = lane & 15, fq = lane >> 4;
    constexpr int N_SCAN = NBH * 4, N_SRET = BS * NH, N_POOLP = MP / 32, N_POOLS = BS / 8;
    constexpr int NIT = N_SCAN + N_SRET + N_POOLP + N_POOLS;
    for (int it = blockIdx.x; it < NIT; it += G) {
        if (it < N_SCAN) {
            const int bh = it >> 2, dv0 = 32 * (it & 3), h = bh % NH;
            const float gC = exp2f(128.f * lg2_gamma(h));
            const bf16_t* vt = VT + ((size_t)bh * HD + dv0 + fr) * SEQ + fq * 8;
            const bf16_t* kt = KT + ((size_t)bh * HD + 16 * w + fr) * SEQ + fq * 8;
            f32x4 acc[2]; acc[0] = (f32x4){0.f, 0.f, 0.f, 0.f}; acc[1] = acc[0];
            bf16x8 A[2][4], B[4];
#pragma unroll
            for (int ks = 0; ks < 4; ++ks) { B[ks] = *(const bf16x8*)(kt + ks * 32); A[0][ks] = *(const bf16x8*)(vt + ks * 32); A[1][ks] = *(const bf16x8*)(vt + (size_t)16 * SEQ + ks * 32); }
#pragma unroll 1
            for (int c = 0; c < NCH; ++c) {
                bf16_t* sp = SPREV + (((size_t)bh * NCH + c) * HD + dv0 + 4 * fq) * HD + 16 * w + fr;
#pragma unroll
                for (int mt = 0; mt < 2; ++mt)
#pragma unroll
                    for (int j = 0; j < 4; ++j) sp[(size_t)(16 * mt + j) * HD] = (bf16_t)f2bf(acc[mt][j]);
                bf16x8 A2[2][4], B2[4];
                const int cn = c + 1 < NCH ? c + 1 : c;
#pragma unroll
                for (int ks = 0; ks < 4; ++ks) { B2[ks] = *(const bf16x8*)(kt + cn * 128 + ks * 32); A2[0][ks] = *(const bf16x8*)(vt + cn * 128 + ks * 32); A2[1][ks] = *(const bf16x8*)(vt + (size_t)16 * SEQ + cn * 128 + ks * 32); }
                acc[0] = acc[0] * gC; acc[1] = acc[1] * gC;
#pragma unroll
                for (int ks = 0; ks < 4; ++ks) { acc[0] = mfma16(A[0][ks], B[ks], acc[0]); acc[1] = mfma16(A[1][ks], B[ks], acc[1]); }
#pragma unroll
                for (int ks = 0; ks < 4; ++ks) { B[ks] = B2[ks]; A[0][ks] = A2[0][ks]; A[1][ks] = A2[1][ks]; }
            }
            float* o = out + O_RP + ((size_t)bh * HD + 16 * w + fr) * HD + dv0 + 4 * fq;
            *(f32x4*)o = acc[0]; *(f32x4*)(o + 16) = acc[1];
        } else if (it < N_SCAN + N_SRET) {
            const int id = it - N_SCAN, bs = id / NH, h = id % NH, row = MP + bs;
            const float gam = 1.0f - exp2f(-5.0f - (float)h);
            LAS float* red = (LAS float*)lds;
            LAS float* qv = red + 16 * 128;
            if (tid < 256) { const int i = tid & 127; qv[tid] = bf2f((tid < 128 ? Q : Kb)[(size_t)row * RW + h * HD + i]); }
            LDS_SYNC();
            const int dkg = tid >> 5, c4 = tid & 31;
            const f32x4 v4 = *(const f32x4*)(VS + (size_t)bs * RW + h * HD + 4 * c4);
            const float* s0 = state_ret + (((size_t)bs * NH + h) * HD + dkg * 8) * HD + 4 * c4;
            float* sn = out + O_RS + (((size_t)bs * NH + h) * HD + dkg * 8) * HD + 4 * c4;
            f32x4 part = (f32x4){0.f, 0.f, 0.f, 0.f};
#pragma unroll
            for (int i = 0; i < 8; ++i) {
                const f32x4 s = *(const f32x4*)(s0 + (size_t)i * HD);
                const float qd = qv[dkg * 8 + i], kd = qv[128 + dkg * 8 + i];
                part = part + s * qd;
                *(f32x4*)(sn + (size_t)i * HD) = s * gam + v4 * kd;
            }
            *(LAS f32x4*)(red + dkg * 128 + 4 * c4) = part;
            LDS_SYNC();
            if (w == 0) {
                float qk = 0.f;
#pragma unroll
                for (int i = 0; i < 2; ++i) qk += qv[lane + 64 * i] * qv[128 + lane + 64 * i];
                qk = wave_sum(qk);
                float o[2], s1 = 0.f;
#pragma unroll
                for (int i = 0; i < 2; ++i) { const int dv = lane + 64 * i; float a = 0.f;
#pragma unroll
                    for (int g = 0; g < 16; ++g) a += red[g * 128 + dv];
                    o[i] = qk * VS[(size_t)bs * RW + h * HD + dv] + gam * a; s1 += o[i]; }
                const float mu = wave_sum(s1) * (1.f / HD);
                float s2 = 0.f;
#pragma unroll
                for (int i = 0; i < 2; ++i) { o[i] -= mu; s2 += o[i] * o[i]; }
                const float rstd = rsqrtf(wave_sum(s2) * (1.f / HD) + EPS);
#pragma unroll
                for (int i = 0; i < 2; ++i) { const int dv = lane + 64 * i;
                    MIX[(size_t)row * D + PW + h * HD + dv] = (bf16_t)f2bf(o[i] * rstd * bf2f(GATE[(size_t)row * RW + h * HD + dv])); }
            }
            LDS_SYNC();
        } else if (it < N_SCAN + N_SRET + N_POOLP) {
            const int tile = it - N_SCAN - N_SRET, r0 = tile * 32, t0 = r0 & (SEQ - 1);
            LAS float* ub = (LAS float*)lds;
            LAS float* pb = ub + 47 * 256;
            for (int idx = tid; idx < 47 * 256; idx += 512) { const int rr = idx >> 8, ch = idx & 255, t = t0 - 15 + rr;
                ub[idx] = t >= 0 ? bf2f(U[(size_t)(r0 - 15 + rr) * PW + ch]) : 0.f; }
            LDS_SYNC();
            { const int ch = tid & 255, g = ch >> 6, wn = 2 << g;
#pragma unroll 1
              for (int i = 0; i < 16; ++i) { const int tt = (tid >> 8) * 16 + i; float s = 0.f;
                  for (int k = 0; k < wn; ++k) s += ub[(15 + tt - k) * 256 + ch];
                  const int cnt = min(wn, t0 + tt + 1);
                  pb[tt * 256 + ch] = s / (float)cnt - ub[(15 + tt) * 256 + ch]; } }
            LDS_SYNC();
            pool_matvec(pb, 32, r0, w_pool, ls_pool, MIX);
            LDS_SYNC();
        } else {
            const int s0i = (it - N_SCAN - N_SRET - N_POOLP) * 8;
            LAS float* pb = (LAS float*)lds;
            { const int ch = tid & 255, g = ch >> 6, wn = 2 << g;
#pragma unroll 1
              for (int i = 0; i < 4; ++i) { const int sidx = (tid >> 8) * 4 + i, bs = s0i + sidx;
                  const float un = bf2f(U[(size_t)(MP + bs) * PW + ch]); float s = un;
                  for (int j = 0; j < 15; ++j) { const float hv = state_pool[((size_t)bs * 15 + j) * PW + ch];
                      if (j >= 16 - wn) s += hv;
                      if (j >= 1) out[O_PS + ((size_t)bs * 15 + j - 1) * PW + ch] = hv; }
                  pb[sidx * 256 + ch] = s / (float)wn - un; } }
            LDS_SYNC();
            pool_matvec(pb, 8, MP + s0i, w_pool, ls_pool, MIX);
            LDS_SYNC();
        }
    }
}

constexpr int RT_STRIDE = 272, RT_TILE = 128 * RT_STRIDE;
__device__ __forceinline__ bf16x8 rt_frag(const LAS unsigned char* tile, int row, int kel) { return *(const LAS bf16x8*)(tile + row * RT_STRIDE + kel * 2); }
__device__ __forceinline__ void phase4(LAS unsigned char* lds, int G, const bf16_t* Q, const bf16_t* Kb, const bf16_t* VT, const bf16_t* SPREV, const bf16_t* GATE, bf16_t* MIX) {
    const int tid = threadIdx.x, lane = tid & 63, w = __builtin_amdgcn_readfirstlane(tid >> 6), wr = w >> 2, wc = w & 3, fr = lane & 15, fq = lane >> 4;
    LAS unsigned char* Tq = lds; LAS unsigned char* Tk = lds + RT_TILE; LAS unsigned char* Tv = lds + 2 * RT_TILE; LAS unsigned char* Ts = lds + 3 * RT_TILE;
    LAS float* red1 = (LAS float*)(lds + 4 * RT_TILE); LAS float* red2 = red1 + 512;
    for (int it = blockIdx.x; it < NBH * NCH; it += G) {
        const int bh = it / NCH, c = it % NCH, b = bh / NH, h = bh % NH;
        int lf = lane; asm volatile("" : "+v"(lf));
        const int fr = lf & 15, fq = lf >> 4;
        const float lg = lg2_gamma(h);
        const size_t row0 = (size_t)b * SEQ + c * 128;
#pragma unroll
        for (int i = 0; i < 4; ++i) {
            const int idx = tid + 512 * i, row = idx >> 4, ch = idx & 15;
            const u32x4 vq = *(const u32x4*)(Q + (row0 + row) * RW + h * HD + ch * 8);
            const u32x4 vk = *(const u32x4*)(Kb + (row0 + row) * RW + h * HD + ch * 8);
            const u32x4 vv = *(const u32x4*)(VT + ((size_t)bh * HD + row) * SEQ + c * 128 + ch * 8);
            const u32x4 vs = *(const u32x4*)(SPREV + (((size_t)bh * NCH + c) * HD + row) * HD + ch * 8);
            *(LAS u32x4*)(Tq + row * RT_STRIDE + ch * 16) = vq; *(LAS u32x4*)(Tk + row * RT_STRIDE + ch * 16) = vk;
            *(LAS u32x4*)(Tv + row * RT_STRIDE + ch * 16) = vv; *(LAS u32x4*)(Ts + row * RT_STRIDE + ch * 16) = vs;
        }
        BLOCK_SYNC();
        f32x4 sa[4][2], o[4][2];
#pragma unroll
        for (int mt = 0; mt < 4; ++mt)
#pragma unroll
            for (int nt = 0; nt < 2; ++nt) { sa[mt][nt] = (f32x4){0.f, 0.f, 0.f, 0.f}; o[mt][nt] = sa[mt][nt]; }
#pragma unroll 1
        for (int ks = 0; ks < 4; ++ks) {
            bf16x8 a[4], bk[2], bs[2];
#pragma unroll
            for (int mt = 0; mt < 4; ++mt) a[mt] = rt_frag(Tq, 64 * wr + 16 * mt + fr, ks * 32 + fq * 8);
#pragma unroll
            for (int nt = 0; nt < 2; ++nt) { bk[nt] = rt_frag(Tk, 32 * wc + 16 * nt + fr, ks * 32 + fq * 8); bs[nt] = rt_frag(Ts, 32 * wc + 16 * nt + fr, ks * 32 + fq * 8); }
#pragma unroll
            for (int mt = 0; mt < 4; ++mt)
#pragma unroll
                for (int nt = 0; nt < 2; ++nt) { sa[mt][nt] = mfma16(a[mt], bk[nt], sa[mt][nt]); o[mt][nt] = mfma16(a[mt], bs[nt], o[mt][nt]); }
        }
        LDS_SYNC();
#pragma unroll
        for (int mt = 0; mt < 4; ++mt)
#pragma unroll
            for (int j = 0; j < 4; ++j) {
                const int i = 64 * wr + 16 * mt + 4 * fq + j;
                const float qd = exp2f((float)(i + 1) * lg);
#pragma unroll
                for (int nt = 0; nt < 2; ++nt) {
                    const int jj = 32 * wc + 16 * nt + fr, dl = i - jj;
                    const float mv = dl >= 0 ? sa[mt][nt][j] * exp2f((float)dl * lg) : 0.f;
                    *(LAS bf16_t*)(Tk + i * RT_STRIDE + jj * 2) = (bf16_t)f2bf(mv);
                    o[mt][nt][j] *= qd;
                }
                asm volatile("" ::: "memory");
            }
        LDS_SYNC();
#pragma unroll 1
        for (int ks = 0; ks < 4; ++ks) {
            if (32 * ks > 64 * wr + 63) continue;
            bf16x8 a[4], bv[2];
#pragma unroll
            for (int mt = 0; mt < 4; ++mt) a[mt] = rt_frag(Tk, 64 * wr + 16 * mt + fr, ks * 32 + fq * 8);
#pragma unroll
            for (int nt = 0; nt < 2; ++nt) bv[nt] = rt_frag(Tv, 32 * wc + 16 * nt + fr, ks * 32 + fq * 8);
#pragma unroll
            for (int mt = 0; mt < 4; ++mt)
#pragma unroll
                for (int nt = 0; nt < 2; ++nt) o[mt][nt] = mfma16(a[mt], bv[nt], o[mt][nt]);
        }
#pragma unroll
        for (int mt = 0; mt < 4; ++mt)
#pragma unroll
            for (int j = 0; j < 4; ++j) {
                float s = o[mt][0][j] + o[mt][1][j];
                s += __shfl_xor(s, 1); s += __shfl_xor(s, 2); s += __shfl_xor(s, 4); s += __shfl_xor(s, 8);
                if (fr == 0) red1[(64 * wr + 16 * mt + 4 * fq + j) * 4 + wc] = s;
            }
        LDS_SYNC();
#pragma unroll
        for (int mt = 0; mt < 4; ++mt)
#pragma unroll
            for (int j = 0; j < 4; ++j) {
                const int i = 64 * wr + 16 * mt + 4 * fq + j;
                const f32x4 rs = *(const LAS f32x4*)(red1 + i * 4);
                const float mu = ((rs[0] + rs[1]) + (rs[2] + rs[3])) * (1.f / HD);
                o[mt][0][j] -= mu; o[mt][1][j] -= mu;
                float s = o[mt][0][j] * o[mt][0][j] + o[mt][1][j] * o[mt][1][j];
                s += __shfl_xor(s, 1); s += __shfl_xor(s, 2); s += __shfl_xor(s, 4); s += __shfl_xor(s, 8);
                if (fr == 0) red2[i * 4 + wc] = s;
            }
        LDS_SYNC();
#pragma unroll
        for (int mt = 0; mt < 4; ++mt)
#pragma unroll
            for (int j = 0; j < 4; ++j) {
                const int i = 64 * wr + 16 * mt + 4 * fq + j;
                const f32x4 rs = *(const LAS f32x4*)(red2 + i * 4);
                const float rstd = rsqrtf(((rs[0] + rs[1]) + (rs[2] + rs[3])) * (1.f / HD) + EPS);
#pragma unroll
                for (int nt = 0; nt < 2; ++nt) {
                    const int dv = 32 * wc + 16 * nt + fr;
                    const float gt = bf2f(GATE[(row0 + i) * RW + h * HD + dv]);
                    MIX[(row0 + i) * D + PW + h * HD + dv] = (bf16_t)f2bf(o[mt][nt][j] * rstd * gt);
                }
                asm volatile("" ::: "memory");
            }
        BLOCK_SYNC();
    }
}

__device__ __forceinline__ void phase_fix(int G, const float* AT, const float* AH, const float* BH, const float* cw, const float* cb, bf16_t* Gb) {
    const int total = 64 * 2 * DFF;
    for (int idx = blockIdx.x * 512 + threadIdx.x; idx < total; idx += G * 512) {
        const int pm = idx / (2 * DFF), rem = idx % (2 * DFF), rr = rem / DFF, c = rem % DFF;
        if ((pm & 7) == 0) continue;
        const float a_m1 = rr == 0 ? AT[((size_t)(pm - 1) * 2 + 1) * DFF + c] : AH[((size_t)pm * 2 + 0) * DFF + c];
        const float a_m2 = rr == 0 ? AT[((size_t)(pm - 1) * 2 + 0) * DFF + c] : AT[((size_t)(pm - 1) * 2 + 1) * DFF + c];
        const float a0 = AH[((size_t)pm * 2 + rr) * DFF + c], bb = BH[((size_t)pm * 2 + rr) * DFF + c];
        const float cv = cw[c] * a_m2 + cw[DFF + c] * a_m1 + cw[2 * DFF + c] * a0 + cb[c];
        Gb[((size_t)pm * 256 + rr) * DFF + c] = (bf16_t)f2bf(silu_f(cv) * bb);
    }
}

#define XB_TMO      128
#define XB_XCNT(j)  (256  + 64 * (j))
#define XB_XSUB(j)  (1280 + 64 * (j))
#define XB_XGEN(j)  (2304 + 64 * (j))
#define XB_TOP      3328
#define XB_TOPGEN   3392
#define XCD_BAR_WORDS 3456
#define XB_SPIN_CAP (1u << 18)

__device__ __forceinline__ unsigned xb_ld(unsigned* p)              { return __hip_atomic_load(p, __ATOMIC_RELAXED, __HIP_MEMORY_SCOPE_AGENT); }
__device__ __forceinline__ unsigned xb_add(unsigned* p, unsigned v) { return __hip_atomic_fetch_add(p, v, __ATOMIC_RELAXED, __HIP_MEMORY_SCOPE_AGENT); }
__device__ __forceinline__ unsigned xb_xcc_id() { return (unsigned)__builtin_amdgcn_s_getreg((3 << 11) | 20) & 0xFu; }
#define XB_SPIN(cond, bar) do { unsigned _sp = 0; while (cond) { __builtin_amdgcn_s_sleep(1); \
    if ((++_sp & 255u) == 0u) { if (xb_ld(&(bar)[XB_TMO])) break; if (_sp > XB_SPIN_CAP) { atomicAdd(&(bar)[XB_TMO], 1u); break; } } } } while (0)

struct XcdBarrier {
    unsigned* bar; unsigned x;
    volatile LAS unsigned* st;
};

__device__ __forceinline__ XcdBarrier xcd_barrier_post(unsigned* bar, volatile LAS unsigned* st) {
    XcdBarrier b; b.bar = bar; b.x = xb_xcc_id(); b.st = st;
    if (threadIdx.x == 0) (void)xb_add(&bar[XB_XCNT(b.x)], 1u);
    return b;
}
__device__ __forceinline__ void xcd_barrier_complete(unsigned* bar, unsigned x, unsigned& nloc, unsigned& nx) {
    const unsigned G = gridDim.x * gridDim.y * gridDim.z;
    unsigned sum, cnt, mine, sp = 0u;
    for (;;) {
        sum = 0u; cnt = 0u; mine = 0u;
#pragma unroll
        for (unsigned j = 0; j < 16; ++j) { const unsigned c = xb_ld(&bar[XB_XCNT(j)]); sum += c; cnt += (c > 0u) ? 1u : 0u; mine = (j == x) ? c : mine; }
        if (sum == G) break;
        __builtin_amdgcn_s_sleep(1);
        if ((++sp & 255u) == 0u) { if (xb_ld(&bar[XB_TMO])) break; if (sp > XB_SPIN_CAP) { atomicAdd(&bar[XB_TMO], 1u); break; } }
    }
    nloc = mine > 0u ? mine : 1u; nx = cnt > 0u ? cnt : 1u;
}

__device__ __forceinline__ void xcd_barrier(const XcdBarrier& b) {
    asm volatile("s_waitcnt vmcnt(0)" ::: "memory");
    __syncthreads();
    if (threadIdx.x == 0) {
        unsigned* bar = b.bar;
        __builtin_amdgcn_s_waitcnt(0);
        unsigned nloc = b.st[0], nx = b.st[1];
        if (nloc == 0u) { xcd_barrier_complete(bar, b.x, nloc, nx); b.st[0] = nloc; b.st[1] = nx; }
        const unsigned old = xb_add(&bar[XB_XSUB(b.x)], 1u);
        const unsigned gen = old / nloc;
        if (old + 1u == (gen + 1u) * nloc) {
            __builtin_amdgcn_fence(__ATOMIC_RELEASE, "agent");
            asm volatile("s_waitcnt vmcnt(0)" ::: "memory");
            const unsigned og = xb_add(&bar[XB_TOP], 1u);
            const unsigned tg = og / nx;
            if (og + 1u == (tg + 1u) * nx) xb_add(&bar[XB_TOPGEN], 1u);
            else XB_SPIN(xb_ld(&bar[XB_TOPGEN]) == tg, bar);
            __builtin_amdgcn_fence(__ATOMIC_ACQUIRE, "agent");
            xb_add(&bar[XB_XGEN(b.x)], 1u);
            asm volatile("s_waitcnt vmcnt(0)" ::: "memory");
        } else {
            XB_SPIN(xb_ld(&bar[XB_XGEN(b.x)]) == gen, bar);
            __builtin_amdgcn_fence(__ATOMIC_ACQUIRE, "agent");
            asm volatile("s_waitcnt vmcnt(0)" ::: "memory");
        }
    }
    __syncthreads();
}


struct Args { const float* in[20]; float* out; unsigned char* ws; int ph_lo, ph_hi; };
__global__ void __launch_bounds__(512, 2) hymba_fwd(Args args) {
    extern __shared__ __attribute__((aligned(16))) unsigned char lds_raw[];
    LAS unsigned char* lds = (LAS unsigned char*)lds_raw;
    cg::grid_group grid = cg::this_grid();
    const int G = gridDim.x;
    unsigned char* ws = args.ws; float* out = args.out;
    const float *x_p = args.in[0], *x_s = args.in[1], *c_p = args.in[2], *c_s = args.in[3], *st_pool = args.in[4], *st_ret = args.in[5], *st_conv = args.in[6],
                *g_mix = args.in[7], *g_ffn = args.in[8], *w_ada = args.in[9], *b_ada = args.in[10], *w_in = args.in[11], *w_pool = args.in[12], *ls_pool = args.in[13],
                *w_out = args.in[14], *w_fi = args.in[15], *conv_w = args.in[16], *conv_b = args.in[17], *w_fo = args.in[18], *g_fin = args.in[19];
    float* mod = (float*)(ws + WS_MOD); float* rope = (float*)(ws + WS_ROPE); float* VS = (float*)(ws + WS_VS);
    bf16_t *WTin = (bf16_t*)(ws + WS_WIN), *WTout = (bf16_t*)(ws + WS_WOUT), *WTfi = (bf16_t*)(ws + WS_WFI), *WTfo = (bf16_t*)(ws + WS_WFO);
    float *AT = (float*)(ws + WS_HALO), *AH = AT + HALO_N, *BH = AH + HALO_N;
    bf16_t *RA = (bf16_t*)(ws + WS_RA), *RB = (bf16_t*)(ws + WS_RB), *Ub = (bf16_t*)(ws + WS_U), *GATE = (bf16_t*)(ws + WS_GATE), *Qb = (bf16_t*)(ws + WS_Q), *Kb = (bf16_t*)(ws + WS_K),
           *KT = (bf16_t*)(ws + WS_KT), *VT = (bf16_t*)(ws + WS_VT), *Gb = (bf16_t*)(ws + WS_G);
    bf16_t* SPREV = (bf16_t*)(out + O_YP);
    const int lo = args.ph_lo, hi = args.ph_hi;
#if MK_XCD_BARRIER && !MK_MULTI_LAUNCH
    volatile LAS unsigned* bst = (volatile LAS unsigned*)(lds + LDS_BYTES - 64);
    if (threadIdx.x < 4) bst[threadIdx.x] = 0u;
    __syncthreads();
    XcdBarrier xbar = xcd_barrier_post((unsigned*)(ws + WS_CTL), bst);
#endif
#ifndef PH_MASK
#define PH_MASK 0x7ff
#endif
#define IN(k) (((PH_MASK >> (k)) & 1) && lo <= (k) && (k) < hi)
#if MK_XCD_BARRIER && !MK_MULTI_LAUNCH
#define SEAM(k) do { if (IN(k) && IN((k) + 1)) { if ((k) == 0) grid.sync(); else xcd_barrier(xbar); } } while (0)
#else
#define SEAM(k) do { if (IN(k) && IN((k) + 1)) { grid.sync(); } } while (0)
#endif

    if (IN(0)) phase0(lds, G, c_p, c_s, w_ada, b_ada, w_in, w_out, w_fi, w_fo, mod, rope, WTin, WTout, WTfi, WTfo);
    SEAM(0);
    if (IN(1)) norm_phase<0>(G, x_p, x_s, g_mix, mod, 0, 1, RA, nullptr);
    SEAM(1);
    if (IN(2)) {
        pg8::Gemm g{RA, WTin, MPAD, INC, D}; pg8::StaticOrder S; S.init(MPAD, INC, G, (int)blockIdx.x);
        EpiIn E{Ub, Qb, Kb, KT, VT, GATE, VS, rope, out};
        pg8::gemm_phase<EpiIn, pg8::StaticOrder, true, true>(lds, g, S, E);
    }
    SEAM(2);
    if (IN(3)) phase3(lds, G, Ub, Qb, Kb, KT, VT, GATE, VS, st_pool, st_ret, w_pool, ls_pool, SPREV, RB, out);
    SEAM(3);
    if (IN(4)) phase4(lds, G, Qb, Kb, VT, SPREV, GATE, RB);
    SEAM(4);
    if (IN(5)) {
        pg8::Gemm g{RB, WTout, MPAD, D, D}; pg8::StaticOrder S; S.init(MPAD, D, G, (int)blockIdx.x);
        EpiRes E{x_p, x_s, mod, 2, out + O_YP, 0};
        pg8::gemm_phase<EpiRes, pg8::StaticOrder, true, true>(lds, g, S, E);
    }
    SEAM(5);
    if (IN(6)) norm_phase<1>(G, nullptr, nullptr, g_ffn, mod, 3, 4, RA, out + O_YP);
    SEAM(6);
    if (IN(7)) {
        pg8::Gemm g{RA, WTfi, MPAD, NFF, D}; pg8::StaticOrder S; S.init(MPAD, NFF, G, (int)blockIdx.x);
        EpiFfn E{Gb, AT, AH, BH, conv_w, conv_b, st_conv, out, (LAS float*)(lds + LDS_X)};
        pg8::gemm_phase<EpiFfn, pg8::StaticOrder, true, true>(lds, g, S, E);
    }
    SEAM(7);
    if (IN(8)) phase_fix(G, AT, AH, BH, conv_w, conv_b, Gb);
    SEAM(8);
    if (IN(9)) {
        pg8::Gemm g{Gb, WTfo, MPAD, D, DFF}; pg8::StaticOrder S; S.init(MPAD, D, G, (int)blockIdx.x);
        EpiRes E{nullptr, nullptr, mod, 5, out + O_YP, 1};
        pg8::gemm_phase<EpiRes, pg8::StaticOrder, true, true>(lds, g, S, E);
    }
    SEAM(9);
    if (IN(10)) norm_phase<2>(G, nullptr, nullptr, g_fin, nullptr, 0, 0, nullptr, out + O_YP);
#undef IN
#undef SEAM
}

extern "C" void kernel_launch(void* const* d_in, const int* in_sizes, int n_in, void* d_out, int out_size, void* d_ws, size_t ws_size, hipStream_t stream) {
    static int grid = 0;
    if (grid == 0) {
        if (n_in != 20 || (size_t)out_size != O_END || ws_size < WS_END) { fprintf(stderr, "kernel_launch: unexpected problem shape (n_in %d, out %d, ws %zu)\n", n_in, out_size, ws_size); grid = -1; return; }
        int dev = 0, cus = 0, per_cu = 0;
        (void)hipGetDevice(&dev); (void)hipDeviceGetAttribute(&cus, hipDeviceAttributeMultiprocessorCount, dev);
        if (hipFuncSetAttribute((const void*)hymba_fwd, hipFuncAttributeMaxDynamicSharedMemorySize, LDS_BYTES) != hipSuccess) { fprintf(stderr, "kernel_launch: hipFuncSetAttribute failed\n"); grid = -1; return; }
        if (hipOccupancyMaxActiveBlocksPerMultiprocessor(&per_cu, (const void*)hymba_fwd, 512, LDS_BYTES) != hipSuccess || per_cu < 1) per_cu = 1;
        (void)hipGetLastError();
        grid = cus * per_cu;
        if (grid <= 0) grid = 256;
    }
    if (grid < 0) return;
    Args a{};
    for (int i = 0; i < 20; ++i) a.in[i] = (const float*)d_in[i];
    a.out = (float*)d_out; a.ws = (unsigned char*)d_ws;
#if MK_MULTI_LAUNCH
    for (int ph = 0; ph < NPHASE; ++ph) { a.ph_lo = ph; a.ph_hi = ph + 1; hipLaunchKernelGGL(hymba_fwd, dim3(grid), dim3(512), LDS_BYTES, stream, a); }
#else
    a.ph_lo = 0; a.ph_hi = NPHASE;
#if MK_XCD_BARRIER
    (void)hipMemsetAsync((char*)d_ws + WS_CTL, 0, 16384, stream);
#endif
    void* kargs[] = {&a};
    hipError_t e = hipLaunchCooperativeKernel((const void*)hymba_fwd, dim3(grid), dim3(512), kargs, LDS_BYTES, stream);
    if (e != hipSuccess) fprintf(stderr, "kernel_launch: cooperative launch failed: %s (grid %d)\n", hipGetErrorString(e), grid);
#endif
}
```

```cpp
#include <hip/hip_runtime.h>
#include <hip/hip_cooperative_groups.h>
#include <cstdio>
#include <cstdint>
namespace cg = cooperative_groups;

#ifndef MK_MULTI_LAUNCH
#define MK_MULTI_LAUNCH 0
#endif
#ifndef MK_XCD_BARRIER
#define MK_XCD_BARRIER 1
#endif

namespace pg8 {
#define PG8_LAS __attribute__((address_space(3)))
typedef unsigned short bf16_t;
typedef short bf16x8 __attribute__((ext_vector_type(8)));
typedef float f32x4 __attribute__((ext_vector_type(4)));
typedef unsigned u32x4 __attribute__((ext_vector_type(4)));
constexpr int BM = 256, BK = 64, HALF = 128, HTB = HALF * BK * 2  , STAGE_BYTES = 8 * HTB, NXCD = 8, WGM = 8;

__host__ __device__ __forceinline__ int lds_byte(int r, int c) { const int st = (r >> 4) * 2 + (c >> 5), rr = r & 15, cc = c & 31, ob = rr * 64 + cc * 2; return st * 1024 + (ob ^ (((ob >> 9) & 1) << 5)); }
__host__ __device__ __forceinline__ void stage_rc(int b, int& R, int& C) { const int st = b / 1024, sb = b % 1024, swz = sb ^ (((sb >> 9) & 1) << 5); R = (st >> 1) * 16 + swz / 64; C = (st & 1) * 32 + (swz % 64) / 2; }
__host__ __device__ __forceinline__ int perm32(int rho) { const int n = rho >> 4, i = rho & 15; return 8 * (i >> 2) + 4 * n + (i & 3); }

struct Unit { int pm, pn; };
struct Gemm { const bf16_t* A; const bf16_t* Bt; int M, N, K; };

struct StaticOrder {
    int nM, nN, nwg, G, c;
    __host__ __device__ void init(int M, int N, int G_, int c_) { nM = M / BM; nN = N / BM; nwg = nM * nN; G = G_; c = c_; }
    __host__ __device__ bool next(int i, Unit& u) const {
        const long L = (long)i * G + c; if (L >= nwg) return false;
        int wgid = (int)L; { const int q = nwg / NXCD, r = nwg % NXCD, xcd = wgid % NXCD, off = wgid / NXCD; wgid = (xcd < r ? xcd * (q + 1) : r * (q + 1) + (xcd - r) * q) + off; }
        const int nig = WGM * nN, gid = wgid / nig, fm = gid * WGM, gsz = (nM - fm) < WGM ? (nM - fm) : WGM;
        u.pm = fm + ((wgid % nig) % gsz); u.pn = (wgid % nig) / gsz; return true;
    }
    __device__ __forceinline__ void a_ready(const Unit&) const {}
    __device__ __forceinline__ void done(const Unit&) const {}
};

__device__ __forceinline__ unsigned cvt_pk_bf16(float lo, float hi) { unsigned r; asm volatile("v_cvt_pk_bf16_f32 %0, %1, %2" : "=v"(r) : "v"(lo), "v"(hi)); return r; }
template <class Epi, class Sched, bool ALIGN_EPI = false, bool SP2 = false>
__device__ __forceinline__ void gemm_phase(PG8_LAS unsigned char* lds, const Gemm g, const Sched& S, const Epi& E) {
    const int tid = threadIdx.x, wid = __builtin_amdgcn_readfirstlane(tid >> 6), lane = tid & 63, wr = wid >> 2, wc = wid & 3, fr = lane & 15, fq = lane >> 4;
    const int K = g.K, nt = K / BK;
    unsigned voffA[2], voffB[2];
#pragma unroll
    for (int i = 0; i < 2; ++i) { int R, C; stage_rc(tid * 16 + i * 8192, R, C); const int Rb = Epi::PERM ? ((R & ~31) + perm32(R & 31)) : R;
        voffA[i] = (unsigned)(R * K + C) * 2u; voffB[i] = (unsigned)(Rb * K + C) * 2u; }
    const size_t kstep = (size_t)(BK * 2);
    const size_t hstep = (size_t)HALF * K * 2;
    const size_t tstep = 2 * hstep;
    const unsigned ldsw = (unsigned)wid * 1024u;
    const int aoff = lds_byte(wr * 64 + fr, fq * 8), boff = lds_byte(wc * 32 + fr, fq * 8);
#define PG8_SA(b, h) (((b) * 2 + (h)) * HTB)
#define PG8_SB(b, h) ((4 + (b) * 2 + (h)) * HTB)
#define PG8_STAGE(bufoff, gbase, voff) do { _Pragma("unroll") for (int _i = 0; _i < 2; ++_i) \
        __builtin_amdgcn_global_load_lds((const unsigned*)((const char*)(gbase) + (voff)[_i]), (PG8_LAS unsigned*)(lds + (bufoff) + ldsw + _i * 8192), 16, 0, 0); } while (0)
#define PG8_LDA(dst, b, h) do { _Pragma("unroll") for (int m = 0; m < 4; ++m) _Pragma("unroll") for (int k = 0; k < 2; ++k) dst[m][k] = *(const PG8_LAS bf16x8*)(lds + PG8_SA(b, h) + aoff + m * 2048 + k * 1024); } while (0)
#define PG8_LDB(dst, b, h) do { _Pragma("unroll") for (int n = 0; n < 2; ++n) _Pragma("unroll") for (int k = 0; k < 2; ++k) dst[n][k] = *(const PG8_LAS bf16x8*)(lds + PG8_SB(b, h) + boff + n * 2048 + k * 1024); } while (0)
#define PG8_MMA(ai, bj, At, Bt) do { __builtin_amdgcn_s_setprio(1); _Pragma("unroll") for (int m = 0; m < 4; ++m) _Pragma("unroll") for (int n = 0; n < 2; ++n) _Pragma("unroll") for (int k = 0; k < 2; ++k) \
        acc[ai][bj][m][n] = __builtin_amdgcn_mfma_f32_16x16x32_bf16(Bt[n][k], At[m][k], acc[ai][bj][m][n], 0, 0, 0); __builtin_amdgcn_s_setprio(0); } while (0)
#define PG8_WAIT_V(n) asm volatile("s_waitcnt vmcnt(" #n ")" ::: "memory")
#define PG8_WAIT_L(n) asm volatile("s_waitcnt lgkmcnt(" #n ")" ::: "memory")
#define PG8_BAR __builtin_amdgcn_s_barrier()
#define PG8_SCHED __builtin_amdgcn_sched_barrier(0)
    Unit cur, nxt; int ui = 0;
    if (!S.next(0, cur)) return;
    f32x4 acc[2][2][4][2];
#pragma unroll
    for (int a = 0; a < 2; ++a)
#pragma unroll
        for (int b = 0; b < 2; ++b)
#pragma unroll
            for (int m = 0; m < 4; ++m)
#pragma unroll
                for (int n = 0; n < 2; ++n) acc[a][b][m][n] = (f32x4){0.f, 0.f, 0.f, 0.f};
    bf16x8 At[4][2], B0[2][2], B1[2][2];
    const char* cA = (const char*)g.A + (size_t)cur.pm * tstep; const char* cB = (const char*)g.Bt + (size_t)cur.pn * tstep;
    S.a_ready(cur);
    if constexpr (SP2) {
        PG8_STAGE(PG8_SB(0, 0), cB, voffB); PG8_STAGE(PG8_SB(0, 1), cB + hstep, voffB); PG8_STAGE(PG8_SA(0, 0), cA, voffA); PG8_STAGE(PG8_SA(0, 1), cA + hstep, voffA);
        if (wr == 1) PG8_BAR;
        PG8_WAIT_V(2); PG8_BAR;
        PG8_STAGE(PG8_SB(1, 0), cB + kstep, voffB); PG8_STAGE(PG8_SA(1, 0), cA + kstep, voffA); PG8_STAGE(PG8_SB(1, 1), cB + hstep + kstep, voffB);
        PG8_WAIT_V(6); PG8_BAR;
    } else {
        PG8_STAGE(PG8_SB(0, 0), cB, voffB); PG8_STAGE(PG8_SA(0, 0), cA, voffA); PG8_STAGE(PG8_SB(0, 1), cB + hstep, voffB); PG8_STAGE(PG8_SA(0, 1), cA + hstep, voffA);
        if (wr == 1) PG8_BAR;
        PG8_WAIT_V(4); PG8_BAR;
        PG8_STAGE(PG8_SB(1, 0), cB + kstep, voffB); PG8_STAGE(PG8_SA(1, 0), cA + kstep, voffA); PG8_STAGE(PG8_SB(1, 1), cB + hstep + kstep, voffB);
        PG8_WAIT_V(6); PG8_BAR;
    }
    for (;;) {
        const bool has_next = S.next(ui + 1, nxt);
        const char* nA = has_next ? (const char*)g.A + (size_t)nxt.pm * tstep : cA; const char* nB = has_next ? (const char*)g.Bt + (size_t)nxt.pn * tstep : cB;
        for (int t = 0; t < nt; t += 2) {
            const bool last = (t == nt - 2);
            const char* a1 = cA + (size_t)(t + 1) * kstep;
            const char* a2 = last ? nA : cA + (size_t)(t + 2) * kstep; const char* b2 = last ? nB : cB + (size_t)(t + 2) * kstep;
            const char* a3 = a2 + kstep; const char* b3 = b2 + kstep;
            if (last && has_next) S.a_ready(nxt);
            if constexpr (SP2) {
            PG8_LDB(B0, 0, 0); PG8_LDB(B1, 0, 1); PG8_SCHED; PG8_LDA(At, 0, 0); PG8_STAGE(PG8_SA(1, 1), a1 + hstep, voffA);
            PG8_WAIT_V(8); PG8_WAIT_L(0); PG8_BAR; PG8_MMA(0, 0, At, B0); PG8_MMA(0, 1, At, B1); PG8_BAR; PG8_SCHED;
            PG8_LDA(At, 0, 1); PG8_STAGE(PG8_SB(0, 0), b2, voffB); PG8_STAGE(PG8_SB(0, 1), b2 + hstep, voffB); PG8_STAGE(PG8_SA(0, 0), a2, voffA);
            PG8_WAIT_V(8); PG8_WAIT_L(0); PG8_BAR; PG8_MMA(1, 0, At, B0); PG8_MMA(1, 1, At, B1); PG8_BAR; PG8_SCHED;
            PG8_LDB(B0, 1, 0); PG8_LDB(B1, 1, 1); PG8_SCHED; PG8_LDA(At, 1, 0); PG8_STAGE(PG8_SA(0, 1), a2 + hstep, voffA);
            PG8_WAIT_V(8); PG8_WAIT_L(0); PG8_BAR; PG8_MMA(0, 0, At, B0); PG8_MMA(0, 1, At, B1); PG8_BAR; PG8_SCHED;
            PG8_LDA(At, 1, 1); PG8_STAGE(PG8_SB(1, 0), b3, voffB); PG8_STAGE(PG8_SB(1, 1), b3 + hstep, voffB); PG8_STAGE(PG8_SA(1, 0), a3, voffA);
            PG8_WAIT_V(8); PG8_WAIT_L(0); PG8_BAR; PG8_MMA(1, 0, At, B0); PG8_MMA(1, 1, At, B1); PG8_BAR; PG8_SCHED;
            } else {
            PG8_LDB(B0, 0, 0); PG8_SCHED; PG8_LDA(At, 0, 0); PG8_STAGE(PG8_SA(1, 1), a1 + hstep, voffA);
            PG8_WAIT_L(8); PG8_BAR; PG8_WAIT_L(0); PG8_MMA(0, 0, At, B0); PG8_BAR; PG8_SCHED;
            PG8_LDB(B1, 0, 1); PG8_STAGE(PG8_SB(0, 0), b2, voffB);
            PG8_BAR; PG8_WAIT_L(0); PG8_MMA(0, 1, At, B1); PG8_BAR;
            PG8_LDA(At, 0, 1); PG8_STAGE(PG8_SA(0, 0), a2, voffA);
            PG8_BAR; PG8_WAIT_L(0); PG8_MMA(1, 0, At, B0); PG8_BAR; PG8_SCHED;
            PG8_STAGE(PG8_SB(0, 1), b2 + hstep, voffB);
            PG8_WAIT_V(6); PG8_BAR; PG8_MMA(1, 1, At, B1); PG8_BAR;
            PG8_LDB(B0, 1, 0); PG8_SCHED; PG8_LDA(At, 1, 0); PG8_STAGE(PG8_SA(0, 1), a2 + hstep, voffA);
            PG8_WAIT_L(8); PG8_BAR; PG8_WAIT_L(0); PG8_MMA(0, 0, At, B0); PG8_BAR; PG8_SCHED;
            PG8_LDB(B1, 1, 1); PG8_STAGE(PG8_SB(1, 0), b3, voffB);
            PG8_BAR; PG8_WAIT_L(0); PG8_MMA(0, 1, At, B1); PG8_BAR;
            PG8_LDA(At, 1, 1); PG8_STAGE(PG8_SA(1, 0), a3, voffA);
            PG8_BAR; PG8_WAIT_L(0); PG8_MMA(1, 0, At, B0); PG8_BAR; PG8_SCHED;
            PG8_STAGE(PG8_SB(1, 1), b3 + hstep, voffB);
            PG8_WAIT_V(6); PG8_BAR; PG8_MMA(1, 1, At, B1); PG8_BAR;
            }
        }
        if constexpr (ALIGN_EPI) { if (wr == 0) PG8_BAR; }
        if constexpr (!Epi::AFTER_DRAIN) { E(acc, cur, wr, wc, fr, fq); S.done(cur); }
        if (!has_next) break;
#pragma unroll
        for (int a = 0; a < 2; ++a)
#pragma unroll
            for (int b = 0; b < 2; ++b)
#pragma unroll
                for (int m = 0; m < 4; ++m)
#pragma unroll
                    for (int n = 0; n < 2; ++n) acc[a][b][m][n] = (f32x4){0.f, 0.f, 0.f, 0.f};
        cur = nxt; cA = nA; cB = nB; ++ui;
        if constexpr (ALIGN_EPI) { if (wr == 1) PG8_BAR; }
    }
    PG8_WAIT_V(0);
    if constexpr (!ALIGN_EPI) { if (wr == 0) PG8_BAR; }
    PG8_BAR;
    if constexpr (Epi::AFTER_DRAIN) { E.fused(acc, cur, wr, wc, fr, fq, lds, wid, lane); S.done(cur); }
#undef PG8_SA
#undef PG8_SB
#undef PG8_STAGE
#undef PG8_LDA
#undef PG8_LDB
#undef PG8_MMA
#undef PG8_WAIT_V
#undef PG8_WAIT_L
#undef PG8_BAR
#undef PG8_SCHED
}
}

#define LAS __attribute__((address_space(3)))
typedef unsigned short bf16_t;
typedef float f32x4 __attribute__((ext_vector_type(4)));
typedef short bf16x8 __attribute__((ext_vector_type(8)));
typedef unsigned u32x4 __attribute__((ext_vector_type(4)));
typedef unsigned u32x2 __attribute__((ext_vector_type(2)));

constexpr int D = 1024, BP = 8, SEQ = 2048, MP = BP * SEQ, BS = 128, MR = MP + BS, MPAD = 16640;
constexpr int PW = 256, RW = 768, NH = 6, HD = 128, INC = 3328, DFF = 2816, NFF = 5632, NMODC = 6 * D;
constexpr int NCH = SEQ / 128, NBH = BP * NH;
constexpr float EPS = 1e-6f;
constexpr size_t O_YP = 0, O_YS = 16777216, O_PP = 16908288, O_RP = 16939008, O_CP = 17725440, O_PS = 17770496, O_RS = 18262016, O_CS = 30844928, O_END = 31565824;
constexpr size_t MiB = 1u << 20;
constexpr size_t WS_CTL = 0, WS_MOD = 1 * MiB, WS_ROPE = 5 * MiB, WS_VS = 7 * MiB, WS_WIN = 8 * MiB, WS_WOUT = 15 * MiB, WS_WFI = 17 * MiB, WS_WFO = 28 * MiB,
                 WS_HALO = 34 * MiB, WS_RA = 40 * MiB, WS_RB = 73 * MiB, WS_U = 106 * MiB, WS_GATE = 115 * MiB, WS_Q = 140 * MiB, WS_K = 165 * MiB,
                 WS_KT = 190 * MiB, WS_VT = 214 * MiB, WS_G = 140 * MiB, WS_END = 238 * MiB;
constexpr size_t HALO_N = (size_t)65 * 2 * DFF;
constexpr int LDS_BYTES = 147456;
constexpr int LDS_X = 131072;
constexpr int NPHASE = 11;

__device__ __forceinline__ float bf2f(unsigned v) { return __uint_as_float(v << 16); }
__device__ __forceinline__ unsigned f2bf(float f) { unsigned u = __float_as_uint(f); return (u + 0x7fffu + ((u >> 16) & 1u)) >> 16; }
__device__ __forceinline__ unsigned pk2(float lo, float hi) { return pg8::cvt_pk_bf16(lo, hi); }
__device__ __forceinline__ float silu_f(float x) { return x / (1.f + __expf(-x)); }
__device__ __forceinline__ float wave_sum(float v) {
#pragma unroll
    for (int o = 1; o < 64; o <<= 1) v += __shfl_xor(v, o);
    return v;
}
__device__ __forceinline__ float lg2_gamma(int h) { return log2f(1.0f - exp2f(-5.0f - (float)h)); }
__device__ __forceinline__ f32x4 mfma16(bf16x8 a, bf16x8 b, f32x4 c) { return __builtin_amdgcn_mfma_f32_16x16x32_bf16(a, b, c, 0, 0, 0); }
#define BLOCK_SYNC() do { asm volatile("s_waitcnt vmcnt(0) lgkmcnt(0)" ::: "memory"); __builtin_amdgcn_s_barrier(); asm volatile("" ::: "memory"); } while (0)
#define LDS_SYNC() do { asm volatile("s_waitcnt lgkmcnt(0)" ::: "memory"); __builtin_amdgcn_s_barrier(); asm volatile("" ::: "memory"); } while (0)

template <int MAP> __device__ __forceinline__ int wrow_map(int c) {
    if (MAP == 1) return (c & ~127) | (32 * ((c & 63) >> 4) + 16 * ((c & 127) >> 6) + (c & 15));
    if (MAP == 2) { const int a = c < DFF ? c : c - DFF; return 256 * (a >> 7) + (c < DFF ? 0 : 128) + (a & 127); }
    return c;
}
template <int MAP> __device__ __forceinline__ void p0_transpose_item(const float* __restrict__ W, int K, int N, bf16_t* __restrict__ WT, LAS float* scr, int item, int lane) {
    const int nblk = N / 32, kb = item / nblk, nb = item % nblk, k0 = 64 * kb, n0 = 32 * nb;
#pragma unroll 8
    for (int i = 0; i < 32; ++i) { const int kk = 2 * i + (lane >> 5); scr[kk * 33 + (lane & 31)] = W[(size_t)(k0 + kk) * N + n0 + (lane & 31)]; }
    asm volatile("s_waitcnt lgkmcnt(0)" ::: "memory");
    const int c = lane & 7;
#pragma unroll
    for (int j = 0; j < 4; ++j) { const int n = (lane >> 3) + 8 * j; const LAS float* s = scr + (8 * c) * 33 + n;
        u32x4 o; o.x = pk2(s[0 * 33], s[1 * 33]); o.y = pk2(s[2 * 33], s[3 * 33]); o.z = pk2(s[4 * 33], s[5 * 33]); o.w = pk2(s[6 * 33], s[7 * 33]);
        *(u32x4*)(WT + (size_t)wrow_map<MAP>(n0 + n) * K + k0 + 8 * c) = o; }
    asm volatile("s_waitcnt lgkmcnt(0)" ::: "memory");
}

__device__ __forceinline__ void phase0(LAS unsigned char* lds, int G, const float* c_p, const float* c_s, const float* w_ada, const float* b_ada,
                                       const float* w_in, const float* w_out, const float* w_fi, const float* w_fo,
                                       float* mod, float* rope, bf16_t* WTin, bf16_t* WTout, bf16_t* WTfi, bf16_t* WTfo) {
    const int tid = threadIdx.x, lane = tid & 63, w = __builtin_amdgcn_readfirstlane(tid >> 6), fr = lane & 15, fq = lane >> 4;
    LAS float* red = (LAS float*)lds;
    for (int it = blockIdx.x; it < NMODC / 32; it += G) {
        const int n0 = it * 32;
        f32x4 acc[9][2];
#pragma unroll
        for (int mt = 0; mt < 9; ++mt) { acc[mt][0] = (f32x4){0.f, 0.f, 0.f, 0.f}; acc[mt][1] = (f32x4){0.f, 0.f, 0.f, 0.f}; }
#pragma unroll 1
        for (int ks = 0; ks < 4; ++ks) {
            const int k0 = 128 * w + 32 * ks + fq * 8;
            bf16x8 bfr[2];
#pragma unroll
            for (int nt = 0; nt < 2; ++nt) {
                const float* wp = w_ada + (size_t)k0 * NMODC + n0 + 16 * nt + fr;
                float t[8];
#pragma unroll
                for (int j = 0; j < 8; ++j) t[j] = wp[(size_t)j * NMODC];
                u32x4 pk; pk.x = pk2(t[0], t[1]); pk.y = pk2(t[2], t[3]); pk.z = pk2(t[4], t[5]); pk.w = pk2(t[6], t[7]);
                bfr[nt] = __builtin_bit_cast(bf16x8, pk);
            }
#pragma unroll
            for (int mt = 0; mt < 9; ++mt) {
                const int row = 16 * mt + fr;
                u32x4 pk = (u32x4){0u, 0u, 0u, 0u};
                if (row < BP + BS) {
                    const float* cp = (row < BP ? c_p + (size_t)row * D : c_s + (size_t)(row - BP) * D) + k0;
                    const f32x4 a0 = *(const f32x4*)cp, a1 = *(const f32x4*)(cp + 4);
                    pk.x = pk2(silu_f(a0[0]), silu_f(a0[1])); pk.y = pk2(silu_f(a0[2]), silu_f(a0[3]));
                    pk.z = pk2(silu_f(a1[0]), silu_f(a1[1])); pk.w = pk2(silu_f(a1[2]), silu_f(a1[3]));
                }
                const bf16x8 afr = __builtin_bit_cast(bf16x8, pk);
                acc[mt][0] = mfma16(afr, bfr[0], acc[mt][0]);
                acc[mt][1] = mfma16(afr, bfr[1], acc[mt][1]);
            }
        }
#pragma unroll 1
        for (int r = 0; r < 8; ++r) {
            if (w == r) {
#pragma unroll
                for (int mt = 0; mt < 9; ++mt)
#pragma unroll
                    for (int nt = 0; nt < 2; ++nt)
#pragma unroll
                        for (int j = 0; j < 4; ++j) { const int idx = (16 * mt + 4 * fq + j) * 32 + 16 * nt + fr; red[idx] = (r == 0 ? 0.f : red[idx]) + acc[mt][nt][j]; }
            }
            LDS_SYNC();
        }
        for (int idx = tid; idx < (BP + BS) * 32; idx += 512) { const int row = idx >> 5, c = idx & 31; mod[(size_t)row * NMODC + n0 + c] = red[idx] + b_ada[n0 + c]; }
        LDS_SYNC();
    }
    {
        LAS float* scr = (LAS float*)(lds + w * 16384);
        const int gw = blockIdx.x * 8 + w, NGW = G * 8;
        constexpr int I_IN = (D / 64) * (INC / 32), I_OUT = (D / 64) * (D / 32), I_FI = (D / 64) * (NFF / 32), I_FO = (DFF / 64) * (D / 32);
        constexpr int NITEMS = I_IN + I_OUT + I_FI + I_FO;
        for (int it = NITEMS - 1 - gw; it >= 0; it -= NGW) {
            int r = it;
            if (r < I_IN) { p0_transpose_item<1>(w_in, D, INC, WTin, scr, r, lane); continue; } r -= I_IN;
            if (r < I_OUT) { p0_transpose_item<0>(w_out, D, D, WTout, scr, r, lane); continue; } r -= I_OUT;
            if (r < I_FI) { p0_transpose_item<2>(w_fi, D, NFF, WTfi, scr, r, lane); continue; } r -= I_FI;
            p0_transpose_item<0>(w_fo, DFF, D, WTfo, scr, r, lane);
        }
    }
    for (int idx = blockIdx.x * 512 + tid; idx < (SEQ + 1) * 64; idx += G * 512) {
        const int ps = idx >> 6, i = idx & 63;
        const double pos = ps == SEQ ? 16384.0 : (double)ps;
        const double inv = exp(-(double)i * (9.210340371976184 / 64.0));
        double s, c; sincos(pos * inv, &s, &c);
        rope[(size_t)ps * 128 + i] = (float)c; rope[(size_t)ps * 128 + 64 + i] = (float)s;
    }
}

template <int MODE> __device__ __forceinline__ void norm_phase(int G, const float* xp, const float* xs, const float* gvec, const float* mod, int sh_i, int sc_i, bf16_t* H, float* outy) {
    const int tid = threadIdx.x, lane = tid & 63, w = tid >> 6;
    const int gw = blockIdx.x * 8 + w, NGW = G * 8;
    const int nrows = MODE == 2 ? MR : MPAD;
    for (int r = gw; r < nrows; r += NGW) {
        if (MODE != 2 && r >= MR) {
            u32x2* o = (u32x2*)(H + (size_t)r * D) + lane;
#pragma unroll
            for (int j = 0; j < 4; ++j) o[64 * j] = (u32x2){0u, 0u};
            continue;
        }
        const float* src = MODE == 0 ? (r < MP ? xp + (size_t)r * D : xs + (size_t)(r - MP) * D) : outy + (size_t)r * D;
        const f32x4* xr = (const f32x4*)src + lane;
        f32x4 v[4]; float ss = 0.f;
#pragma unroll
        for (int j = 0; j < 4; ++j) { v[j] = xr[64 * j]; ss += (v[j][0] * v[j][0] + v[j][1] * v[j][1]) + (v[j][2] * v[j][2] + v[j][3] * v[j][3]); }
        const float rstd = rsqrtf(wave_sum(ss) * (1.f / D) + EPS);
        if (MODE == 2) {
            f32x4* o = (f32x4*)(outy + (size_t)r * D) + lane;
#pragma unroll
            for (int j = 0; j < 4; ++j) { const f32x4 g4 = ((const f32x4*)gvec)[lane + 64 * j]; o[64 * j] = v[j] * rstd * g4; }
        } else {
            const int nb = r < MP ? (r >> 11) : BP + (r - MP);
            const f32x4* scp = (const f32x4*)(mod + (size_t)nb * NMODC + sc_i * D) + lane;
            const f32x4* shp = (const f32x4*)(mod + (size_t)nb * NMODC + sh_i * D) + lane;
            u32x2* o = (u32x2*)(H + (size_t)r * D) + lane;
#pragma unroll
            for (int j = 0; j < 4; ++j) { const f32x4 g4 = ((const f32x4*)gvec)[lane + 64 * j], sc = scp[64 * j], sh = shp[64 * j];
                const f32x4 y = v[j] * rstd * g4 * (sc + 1.0f) + sh;
                o[64 * j] = (u32x2){pk2(y[0], y[1]), pk2(y[2], y[3])}; }
        }
    }
}

struct EpiIn {
    static constexpr bool PERM = false, AFTER_DRAIN = false;
    bf16_t *U, *Q, *Kb, *KT, *VT, *GATE; float* VS; const float* rope; float* out;
    __device__ __forceinline__ void operator()(const f32x4 (&acc)[2][2][4][2], const pg8::Unit& u, int wr, int wc, int fr, int fq) const {
        const int p0 = 16 * wc + 4 * fq;
#pragma unroll
        for (int bj = 0; bj < 2; ++bj) {
            const int blk = 2 * u.pn + bj;
            const int region = blk < 2 ? 0 : 1 + (blk - 2) / NH, h = blk < 2 ? blk : (blk - 2) % NH;
            const float lg = lg2_gamma(h);
#pragma unroll
            for (int ai = 0; ai < 2; ++ai)
#pragma unroll
                for (int m = 0; m < 4; ++m) {
                    const int r = u.pm * 256 + ai * 128 + wr * 64 + m * 16 + fr;
                    if (r >= MR) continue;
                    const bool samp = r >= MP; const int b = r >> 11, t = r & (SEQ - 1), bs = r - MP;
                    const f32x4 v0 = acc[ai][bj][m][0], v1 = acc[ai][bj][m][1];
                    if (region == 0) {
                        const int c0 = 128 * h + p0;
                        *(u32x2*)(U + (size_t)r * PW + c0) = (u32x2){pk2(v0[0], v0[1]), pk2(v0[2], v0[3])};
                        *(u32x2*)(U + (size_t)r * PW + c0 + 64) = (u32x2){pk2(v1[0], v1[1]), pk2(v1[2], v1[3])};
                        if (samp) { float* o = out + O_PS + ((size_t)bs * 15 + 14) * PW + c0; *(f32x4*)o = v0; *(f32x4*)(o + 64) = v1; }
                        else if (t >= SEQ - 15) { float* o = out + O_PP + ((size_t)b * 15 + (t - (SEQ - 15))) * PW + c0; *(f32x4*)o = v0; *(f32x4*)(o + 64) = v1; }
                    } else if (region == 1 || region == 2) {
                        const float* cs = rope + (size_t)(samp ? SEQ : t) * 128 + p0;
                        const f32x4 c4 = *(const f32x4*)cs, s4 = *(const f32x4*)(cs + 64);
                        f32x4 o1 = v0 * c4 - v1 * s4, o2 = v0 * s4 + v1 * c4;
                        if (region == 2) { o1 = o1 * 0.08838834764831845f; o2 = o2 * 0.08838834764831845f; }
                        bf16_t* dst = (region == 1 ? Q : Kb) + (size_t)r * RW + h * HD + p0;
                        *(u32x2*)dst = (u32x2){pk2(o1[0], o1[1]), pk2(o1[2], o1[3])};
                        *(u32x2*)(dst + 64) = (u32x2){pk2(o2[0], o2[1]), pk2(o2[2], o2[3])};
                        if (region == 2 && !samp) {
                            const float kd = exp2f((float)(127 - (t & 127)) * lg);
                            bf16_t* kt = KT + ((size_t)(b * NH + h) * HD + p0) * SEQ + t;
#pragma unroll
                            for (int e = 0; e < 4; ++e) { kt[(size_t)e * SEQ] = (bf16_t)f2bf(o1[e] * kd); kt[(size_t)(64 + e) * SEQ] = (bf16_t)f2bf(o2[e] * kd); }
                        }
                    } else if (region == 3) {
                        if (samp) { float* o = VS + (size_t)bs * RW + h * HD + p0; *(f32x4*)o = v0; *(f32x4*)(o + 64) = v1; }
                        else {
                            bf16_t* vt = VT + ((size_t)(b * NH + h) * HD + p0) * SEQ + t;
#pragma unroll
                            for (int e = 0; e < 4; ++e) { vt[(size_t)e * SEQ] = (bf16_t)f2bf(v0[e]); vt[(size_t)(64 + e) * SEQ] = (bf16_t)f2bf(v1[e]); }
                        }
                    } else {
                        bf16_t* dst = GATE + (size_t)r * RW + h * HD + p0;
                        *(u32x2*)dst = (u32x2){pk2(silu_f(v0[0]), silu_f(v0[1])), pk2(silu_f(v0[2]), silu_f(v0[3]))};
                        *(u32x2*)(dst + 64) = (u32x2){pk2(silu_f(v1[0]), silu_f(v1[1])), pk2(silu_f(v1[2]), silu_f(v1[3]))};
                    }
                }
        }
    }
};
struct EpiRes {
    static constexpr bool PERM = false, AFTER_DRAIN = false;
    const float *xp, *xs; const float* mod; int gate_i; float* outy; int from_out;
    __device__ __forceinline__ void operator()(const f32x4 (&acc)[2][2][4][2], const pg8::Unit& u, int wr, int wc, int fr, int fq) const {
#pragma unroll
        for (int ai = 0; ai < 2; ++ai)
#pragma unroll
            for (int m = 0; m < 4; ++m) {
                const int r = u.pm * 256 + ai * 128 + wr * 64 + m * 16 + fr;
                if (r >= MR) continue;
                const int nb = r < MP ? (r >> 11) : BP + (r - MP);
                const float* base = from_out ? outy + (size_t)r * D : (r < MP ? xp + (size_t)r * D : xs + (size_t)(r - MP) * D);
                const float* gp = mod + (size_t)nb * NMODC + gate_i * D;
#pragma unroll
                for (int bj = 0; bj < 2; ++bj)
#pragma unroll
                    for (int n = 0; n < 2; ++n) {
                        const int c = u.pn * 256 + bj * 128 + wc * 32 + n * 16 + fq * 4;
                        const f32x4 bv = *(const f32x4*)(base + c), gv = *(const f32x4*)(gp + c);
                        *(f32x4*)(outy + (size_t)r * D + c) = bv + gv * acc[ai][bj][m][n];
                    }
            }
    }
};
struct EpiFfn {
    static constexpr bool PERM = false, AFTER_DRAIN = false;
    bf16_t* Gb; float *AT, *AH, *BH; const float *cw, *cb, *sconv; float* out; LAS float* tail;
    __device__ __forceinline__ void operator()(const f32x4 (&acc)[2][2][4][2], const pg8::Unit& u, int wr, int wc, int fr, int fq) const {
        asm volatile("" : "+v"(fr), "+v"(fq));
        const int lane = fq * 16 + fr, pm = u.pm;
        int ca[2];
#pragma unroll
        for (int n = 0; n < 2; ++n) ca[n] = 128 * u.pn + 32 * wc + 16 * n + 4 * fq;
        if (pm == MP / 256) {
#pragma unroll
            for (int m = 0; m < 4; ++m)
#pragma unroll
                for (int n = 0; n < 2; ++n) {
                    const int bs = wr * 64 + m * 16 + fr;
                    const f32x4 a = acc[0][0][m][n], bb = acc[0][1][m][n];
                    const f32x4 s0 = *(const f32x4*)(sconv + ((size_t)bs * 2 + 0) * DFF + ca[n]), s1 = *(const f32x4*)(sconv + ((size_t)bs * 2 + 1) * DFF + ca[n]);
                    const f32x4 w0 = *(const f32x4*)(cw + ca[n]), w1 = *(const f32x4*)(cw + DFF + ca[n]), w2 = *(const f32x4*)(cw + 2 * DFF + ca[n]), cbv = *(const f32x4*)(cb + ca[n]);
                    const f32x4 cv = w0 * s0 + w1 * s1 + w2 * a + cbv;
                    f32x4 g;
#pragma unroll
                    for (int e = 0; e < 4; ++e) g[e] = silu_f(cv[e]) * bb[e];
                    *(u32x2*)(Gb + (size_t)(MP + bs) * DFF + ca[n]) = (u32x2){pk2(g[0], g[1]), pk2(g[2], g[3])};
                    *(f32x4*)(out + O_CS + ((size_t)bs * 2 + 0) * DFF + ca[n]) = s1;
                    *(f32x4*)(out + O_CS + ((size_t)bs * 2 + 1) * DFF + ca[n]) = a;
                }
            return;
        }
        if (fr >= 14) {
#pragma unroll
            for (int ai = 0; ai < 2; ++ai)
#pragma unroll
                for (int n = 0; n < 2; ++n) {
                    const f32x4 v = acc[ai][0][3][n];
                    *(LAS f32x4*)(tail + (((ai * 2 + wr) * 4 + wc) * 2 + (fr - 14)) * 32 + 16 * n + 4 * fq) = v;
                    if (ai == 1 && wr == 1) {
                        *(f32x4*)(AT + ((size_t)pm * 2 + (fr - 14)) * DFF + ca[n]) = v;
                        if ((pm & 7) == 7) *(f32x4*)(out + O_CP + ((size_t)(pm >> 3) * 2 + (fr - 14)) * DFF + ca[n]) = v;
                    }
                }
        }
        LDS_SYNC();
#pragma unroll
        for (int n = 0; n < 2; ++n) {
            const int can = 128 * u.pn + 32 * wc + 16 * n + 4 * fq;
            const f32x4 w0 = *(const f32x4*)(cw + can), w1 = *(const f32x4*)(cw + DFF + can), w2 = *(const f32x4*)(cw + 2 * DFF + can), cbv = *(const f32x4*)(cb + can);
#pragma unroll
            for (int ai = 0; ai < 2; ++ai) {
                const int s = ai * 2 + wr;
                f32x4 prev = (f32x4){0.f, 0.f, 0.f, 0.f};
                if (s > 0 && fr >= 14) prev = *(const LAS f32x4*)(tail + ((((s - 1) * 4) + wc) * 2 + (fr - 14)) * 32 + 16 * n + 4 * fq);
#pragma unroll
                for (int m = 0; m < 4; ++m) {
                    const int r = pm * 256 + ai * 128 + wr * 64 + m * 16 + fr;
                    const bool top = (s == 0 && m == 0 && fr < 2 && (pm & 7) != 0);
                    const f32x4 cur = acc[ai][0][m][n], bb = acc[ai][1][m][n];
                    f32x4 g;
#pragma unroll
                    for (int e = 0; e < 4; ++e) {
                        const float c1 = __shfl(cur[e], lane - 1), c2 = __shfl(cur[e], lane - 2), q1 = __shfl(prev[e], lane + 15), q2 = __shfl(prev[e], lane + 14);
                        const float a1 = fr >= 1 ? c1 : q1, a2 = fr >= 2 ? c2 : q2;
                        g[e] = silu_f(w0[e] * a2 + w1[e] * a1 + w2[e] * cur[e] + cbv[e]) * bb[e];
                    }
                    if (top) { *(f32x4*)(AH + ((size_t)pm * 2 + fr) * DFF + can) = cur; *(f32x4*)(BH + ((size_t)pm * 2 + fr) * DFF + can) = bb; }
                    else *(u32x2*)(Gb + (size_t)r * DFF + can) = (u32x2){pk2(g[0], g[1]), pk2(g[2], g[3])};
                    prev = cur;
                    asm volatile("" ::: "memory");
                }
            }
        }
    }
};

__device__ __forceinline__ void pool_matvec(LAS float* pbuf, int ntok, int row0, const float* w_pool, const float* ls_pool, bf16_t* MIX) {
    const int tid = threadIdx.x, d = tid & 63, g = (tid >> 6) & 3, half = tid >> 8;
    float wc[64];
#pragma unroll
    for (int c = 0; c < 64; ++c) wc[c] = w_pool[(size_t)(g * 64 + c) * 64 + d];
    const float ls = ls_pool[g * 64 + d];
    const int per = ntok >> 1;
    for (int tt = half * per; tt < (half + 1) * per; ++tt) {
        const LAS f32x4* pp = (const LAS f32x4*)(pbuf + tt * 256 + g * 64);
        float y = 0.f;
#pragma unroll
        for (int c4 = 0; c4 < 16; ++c4) { const f32x4 p4 = pp[c4]; y += p4[0] * wc[4 * c4] + p4[1] * wc[4 * c4 + 1] + p4[2] * wc[4 * c4 + 2] + p4[3] * wc[4 * c4 + 3]; }
        MIX[(size_t)(row0 + tt) * D + g * 64 + d] = (bf16_t)f2bf(y * ls);
    }
}

__device__ __forceinline__ void phase3(LAS unsigned char* lds, int G, const bf16_t* U, const bf16_t* Q, const bf16_t* Kb, const bf16_t* KT, const bf16_t* VT, const bf16_t* GATE,
                                       const float* VS, const float* state_pool, const float* state_ret, const float* w_pool, const float* ls_pool,
                                       bf16_t* SPREV, bf16_t* MIX, float* out) {
    const int tid = threadIdx.x, lane = tid & 63, w = __builtin_amdgcn_readfirstlane(tid >> 6), fr = lane & 15, fq = lane >> 4;
    constexpr int N_SCAN = NBH * 8, N_SRET = BS * NH, N_POOLP = MP / 32, N_POOLS = BS / 8;
    constexpr int NIT = N_SCAN + N_SRET + N_POOLP + N_POOLS;
    for (int it = blockIdx.x; it < NIT; it += G) {
        if (it < N_SCAN) {
            const int bh = it >> 3, dv0 = 32 * ((it >> 1) & 3), dk0 = 64 * (it & 1), h = bh % NH;
            int lf = lane; asm volatile("" : "+v"(lf));
            const int fr = lf & 15, fq = lf >> 4;
            const float gC = exp2f(128.f * lg2_gamma(h));
            LAS float* kv = (LAS float*)lds;
            const bf16_t* vt = VT + ((size_t)bh * HD + dv0 + fr) * SEQ + (2 * w) * 128 + fq * 8;
            const bf16_t* kt = KT + ((size_t)bh * HD + dk0 + fr) * SEQ + (2 * w) * 128 + fq * 8;
            bf16x8 Af[2][2][4];
#pragma unroll
            for (int ci = 0; ci < 2; ++ci)
#pragma unroll
                for (int mt = 0; mt < 2; ++mt)
#pragma unroll
                    for (int ks = 0; ks < 4; ++ks) Af[ci][mt][ks] = *(const bf16x8*)(vt + (size_t)(16 * mt) * SEQ + ci * 128 + ks * 32);
#pragma unroll
            for (int ci = 0; ci < 2; ++ci)
#pragma unroll
                for (int nt = 0; nt < 4; ++nt) {
                    bf16x8 Bf[4];
#pragma unroll
                    for (int ks = 0; ks < 4; ++ks) Bf[ks] = *(const bf16x8*)(kt + (size_t)(16 * nt) * SEQ + ci * 128 + ks * 32);
#pragma unroll
                    for (int mt = 0; mt < 2; ++mt) {
                        f32x4 a = (f32x4){0.f, 0.f, 0.f, 0.f};
#pragma unroll
                        for (int ks = 0; ks < 4; ++ks) a = mfma16(Bf[ks], Af[ci][mt][ks], a);
                        *(LAS f32x4*)(kv + ((2 * w + ci) * 32 + 16 * mt + fr) * 64 + 16 * nt + 4 * fq) = a;
                    }
                }
            LDS_SYNC();
            {
                const int dv = tid >> 4, dk4 = (tid & 15) * 4;
                f32x4 sv = (f32x4){0.f, 0.f, 0.f, 0.f};
                bf16_t* sp = SPREV + (((size_t)bh * NCH) * HD + dv0 + dv) * HD + dk0 + dk4;
#pragma unroll 4
                for (int c = 0; c < NCH; ++c) {
                    *(u32x2*)(sp + (size_t)c * HD * HD) = (u32x2){pk2(sv[0], sv[1]), pk2(sv[2], sv[3])};
                    const f32x4 k4 = *(const LAS f32x4*)(kv + (c * 32 + dv) * 64 + dk4);
                    sv = sv * gC + k4;
                }
                float* o = out + O_RP + ((size_t)bh * HD + dk0 + dk4) * HD + dv0 + dv;
#pragma unroll
                for (int e = 0; e < 4; ++e) o[(size_t)e * HD] = sv[e];
            }
            LDS_SYNC();
        } else if (it < N_SCAN + N_SRET) {
            const int id = it - N_SCAN, bs = id / NH, h = id % NH, row = MP + bs;
            const float gam = 1.0f - exp2f(-5.0f - (float)h);
            LAS float* red = (LAS float*)lds;
            LAS float* qv = red + 16 * 128;
            if (tid < 256) { const int i = tid & 127; qv[tid] = bf2f((tid < 128 ? Q : Kb)[(size_t)row * RW + h * HD + i]); }
            LDS_SYNC();
            const int dkg = tid >> 5, c4 = tid & 31;
            const f32x4 v4 = *(const f32x4*)(VS + (size_t)bs * RW + h * HD + 4 * c4);
            const float* s0 = state_ret + (((size_t)bs * NH + h) * HD + dkg * 8) * HD + 4 * c4;
            float* sn = out + O_RS + (((size_t)bs * NH + h) * HD + dkg * 8) * HD + 4 * c4;
            f32x4 part = (f32x4){0.f, 0.f, 0.f, 0.f};
#pragma unroll
            for (int i = 0; i < 8; ++i) {
                const f32x4 s = *(const f32x4*)(s0 + (size_t)i * HD);
                const float qd = qv[dkg * 8 + i], kd = qv[128 + dkg * 8 + i];
                part = part + s * qd;
                *(f32x4*)(sn + (size_t)i * HD) = s * gam + v4 * kd;
            }
            *(LAS f32x4*)(red + dkg * 128 + 4 * c4) = part;
            LDS_SYNC();
            if (w == 0) {
                float qk = 0.f;
#pragma unroll
                for (int i = 0; i < 2; ++i) qk += qv[lane + 64 * i] * qv[128 + lane + 64 * i];
                qk = wave_sum(qk);
                float o[2], s1 = 0.f;
#pragma unroll
                for (int i = 0; i < 2; ++i) { const int dv = lane + 64 * i; float a = 0.f;
#pragma unroll
                    for (int g = 0; g < 16; ++g) a += red[g * 128 + dv];
                    o[i] = qk * VS[(size_t)bs * RW + h * HD + dv] + gam * a; s1 += o[i]; }
                const float mu = wave_sum(s1) * (1.f / HD);
                float s2 = 0.f;
#pragma unroll
                for (int i = 0; i < 2; ++i) { o[i] -= mu; s2 += o[i] * o[i]; }
                const float rstd = rsqrtf(wave_sum(s2) * (1.f / HD) + EPS);
#pragma unroll
                for (int i = 0; i < 2; ++i) { const int dv = lane + 64 * i;
                    MIX[(size_t)row * D + PW + h * HD + dv] = (bf16_t)f2bf(o[i] * rstd * bf2f(GATE[(size_t)row * RW + h * HD + dv])); }
            }
            LDS_SYNC();
        } else if (it < N_SCAN + N_SRET + N_POOLP) {
            const int tile = it - N_SCAN - N_SRET, r0 = tile * 32, t0 = r0 & (SEQ - 1);
            LAS float* ub = (LAS float*)lds;
            LAS float* pb = ub + 47 * 256;
            for (int idx = tid; idx < 47 * 256; idx += 512) { const int rr = idx >> 8, ch = idx & 255, t = t0 - 15 + rr;
                ub[idx] = t >= 0 ? bf2f(U[(size_t)(r0 - 15 + rr) * PW + ch]) : 0.f; }
            LDS_SYNC();
            { const int ch = tid & 255, g = ch >> 6, wn = 2 << g;
#pragma unroll 1
              for (int i = 0; i < 16; ++i) { const int tt = (tid >> 8) * 16 + i; float s = 0.f;
                  for (int k = 0; k < wn; ++k) s += ub[(15 + tt - k) * 256 + ch];
                  const int cnt = min(wn, t0 + tt + 1);
                  pb[tt * 256 + ch] = s / (float)cnt - ub[(15 + tt) * 256 + ch]; } }
            LDS_SYNC();
            pool_matvec(pb, 32, r0, w_pool, ls_pool, MIX);
            LDS_SYNC();
        } else {
            const int s0i = (it - N_SCAN - N_SRET - N_POOLP) * 8;
            LAS float* pb = (LAS float*)lds;
            { const int ch = tid & 255, g = ch >> 6, wn = 2 << g;
#pragma unroll 1
              for (int i = 0; i < 4; ++i) { const int sidx = (tid >> 8) * 4 + i, bs = s0i + sidx;
                  const float un = bf2f(U[(size_t)(MP + bs) * PW + ch]); float s = un;
                  for (int j = 0; j < 15; ++j) { const float hv = state_pool[((size_t)bs * 15 + j) * PW + ch];
                      if (j >= 16 - wn) s += hv;
                      if (j >= 1) out[O_PS + ((size_t)bs * 15 + j - 1) * PW + ch] = hv; }
                  pb[sidx * 256 + ch] = s / (float)wn - un; } }
            LDS_SYNC();
            pool_matvec(pb, 8, MP + s0i, w_pool, ls_pool, MIX);
            LDS_SYNC();
        }
    }
}

__device__ __forceinline__ void sample_proj_item(LAS unsigned char* lds, int item, const bf16_t* A, const bf16_t* Bt, int K, const float* base, const float* mod, int gate_i, float* outy) {
    const int tid = threadIdx.x, w = __builtin_amdgcn_readfirstlane(tid >> 6), kh = w >> 2, rq = w & 3;
    int lf = tid & 63; asm volatile("" : "+v"(lf));
    const int fr = lf & 15, fq = lf >> 4;
    const int n0 = item * 16, Kh = K >> 1;
    const bf16_t* ap = A + (size_t)(MP + 32 * rq + fr) * K + kh * Kh + fq * 8;
    const bf16_t* bp = Bt + (size_t)(n0 + fr) * K + kh * Kh + fq * 8;
    f32x4 acc[2]; acc[0] = (f32x4){0.f, 0.f, 0.f, 0.f}; acc[1] = acc[0];
#pragma unroll 4
    for (int k = 0; k < Kh; k += 32) {
        const bf16x8 b = *(const bf16x8*)(bp + k), a0 = *(const bf16x8*)(ap + k), a1 = *(const bf16x8*)(ap + (size_t)16 * K + k);
        acc[0] = mfma16(b, a0, acc[0]); acc[1] = mfma16(b, a1, acc[1]);
    }
    LAS f32x4* xr = (LAS f32x4*)lds;
    if (kh == 1) { xr[(rq * 2 + 0) * 64 + lf] = acc[0]; xr[(rq * 2 + 1) * 64 + lf] = acc[1]; }
    LDS_SYNC();
    if (kh == 0) {
#pragma unroll
        for (int mt = 0; mt < 2; ++mt) {
            const f32x4 v = acc[mt] + xr[(rq * 2 + mt) * 64 + lf];
            const int m = 32 * rq + 16 * mt + fr, c = n0 + 4 * fq;
            const f32x4 bv = *(const f32x4*)(base + (size_t)m * D + c), gv = *(const f32x4*)(mod + (size_t)(BP + m) * NMODC + gate_i * D + c);
            *(f32x4*)(outy + (size_t)(MP + m) * D + c) = bv + gv * v;
        }
    }
    LDS_SYNC();
}

constexpr int RT_STRIDE = 272, RT_TILE = 128 * RT_STRIDE;
__device__ __forceinline__ bf16x8 rt_frag(const LAS unsigned char* tile, int row, int kel) { return *(const LAS bf16x8*)(tile + row * RT_STRIDE + kel * 2); }
__device__ __forceinline__ void phase4(LAS unsigned char* lds, int G, const bf16_t* Q, const bf16_t* Kb, const bf16_t* VT, const bf16_t* SPREV, const bf16_t* GATE, bf16_t* MIX,
                                       const bf16_t* WTout, const float* x_s, const float* mod, float* outy) {
    const int tid = threadIdx.x, lane = tid & 63, w = __builtin_amdgcn_readfirstlane(tid >> 6), wr = w >> 2, wc = w & 3, fr = lane & 15, fq = lane >> 4;
    LAS unsigned char* Tq = lds; LAS unsigned char* Tk = lds + RT_TILE; LAS unsigned char* Tv = lds + 2 * RT_TILE; LAS unsigned char* Ts = lds + 3 * RT_TILE;
    LAS float* red1 = (LAS float*)(lds + 4 * RT_TILE); LAS float* red2 = red1 + 512;
    for (int it = blockIdx.x; it < NBH * NCH + D / 16; it += G) {
        if (it >= NBH * NCH) { sample_proj_item(lds, it - NBH * NCH, MIX, WTout, D, x_s, mod, 2, outy); continue; }
        const int bh = it / NCH, c = it % NCH, b = bh / NH, h = bh % NH;
        int lf = lane; asm volatile("" : "+v"(lf));
        const int fr = lf & 15, fq = lf >> 4;
        const float lg = lg2_gamma(h);
        const size_t row0 = (size_t)b * SEQ + c * 128;
#pragma unroll
        for (int i = 0; i < 4; ++i) {
            const int idx = tid + 512 * i, row = idx >> 4, ch = idx & 15;
            const u32x4 vq = *(const u32x4*)(Q + (row0 + row) * RW + h * HD + ch * 8);
            const u32x4 vk = *(const u32x4*)(Kb + (row0 + row) * RW + h * HD + ch * 8);
            const u32x4 vv = *(const u32x4*)(VT + ((size_t)bh * HD + row) * SEQ + c * 128 + ch * 8);
            const u32x4 vs = *(const u32x4*)(SPREV + (((size_t)bh * NCH + c) * HD + row) * HD + ch * 8);
            *(LAS u32x4*)(Tq + row * RT_STRIDE + ch * 16) = vq; *(LAS u32x4*)(Tk + row * RT_STRIDE + ch * 16) = vk;
            *(LAS u32x4*)(Tv + row * RT_STRIDE + ch * 16) = vv; *(LAS u32x4*)(Ts + row * RT_STRIDE + ch * 16) = vs;
        }
        BLOCK_SYNC();
        f32x4 sa[4][2], o[4][2];
#pragma unroll
        for (int mt = 0; mt < 4; ++mt)
#pragma unroll
            for (int nt = 0; nt < 2; ++nt) { sa[mt][nt] = (f32x4){0.f, 0.f, 0.f, 0.f}; o[mt][nt] = sa[mt][nt]; }
#pragma unroll 1
        for (int ks = 0; ks < 4; ++ks) {
            bf16x8 a[4], bk[2], bs[2];
#pragma unroll
            for (int mt = 0; mt < 4; ++mt) a[mt] = rt_frag(Tq, 64 * wr + 16 * mt + fr, ks * 32 + fq * 8);
#pragma unroll
            for (int nt = 0; nt < 2; ++nt) { bk[nt] = rt_frag(Tk, 32 * wc + 16 * nt + fr, ks * 32 + fq * 8); bs[nt] = rt_frag(Ts, 32 * wc + 16 * nt + fr, ks * 32 + fq * 8); }
#pragma unroll
            for (int mt = 0; mt < 4; ++mt)
#pragma unroll
                for (int nt = 0; nt < 2; ++nt) { sa[mt][nt] = mfma16(a[mt], bk[nt], sa[mt][nt]); o[mt][nt] = mfma16(a[mt], bs[nt], o[mt][nt]); }
        }
        LDS_SYNC();
#pragma unroll
        for (int mt = 0; mt < 4; ++mt)
#pragma unroll
            for (int j = 0; j < 4; ++j) {
                const int i = 64 * wr + 16 * mt + 4 * fq + j;
                const float qd = exp2f((float)(i + 1) * lg);
#pragma unroll
                for (int nt = 0; nt < 2; ++nt) {
                    const int jj = 32 * wc + 16 * nt + fr, dl = i - jj;
                    const float mv = dl >= 0 ? sa[mt][nt][j] * exp2f((float)dl * lg) : 0.f;
                    *(LAS bf16_t*)(Tk + i * RT_STRIDE + jj * 2) = (bf16_t)f2bf(mv);
                    o[mt][nt][j] *= qd;
                }
                asm volatile("" ::: "memory");
            }
        LDS_SYNC();
#pragma unroll 1
        for (int ks = 0; ks < 4; ++ks) {
            if (32 * ks > 64 * wr + 63) continue;
            bf16x8 a[4], bv[2];
#pragma unroll
            for (int mt = 0; mt < 4; ++mt) a[mt] = rt_frag(Tk, 64 * wr + 16 * mt + fr, ks * 32 + fq * 8);
#pragma unroll
            for (int nt = 0; nt < 2; ++nt) bv[nt] = rt_frag(Tv, 32 * wc + 16 * nt + fr, ks * 32 + fq * 8);
#pragma unroll
            for (int mt = 0; mt < 4; ++mt)
#pragma unroll
                for (int nt = 0; nt < 2; ++nt) o[mt][nt] = mfma16(a[mt], bv[nt], o[mt][nt]);
        }
#pragma unroll
        for (int mt = 0; mt < 4; ++mt)
#pragma unroll
            for (int j = 0; j < 4; ++j) {
                float s = o[mt][0][j] + o[mt][1][j];
                s += __shfl_xor(s, 1); s += __shfl_xor(s, 2); s += __shfl_xor(s, 4); s += __shfl_xor(s, 8);
                if (fr == 0) red1[(64 * wr + 16 * mt + 4 * fq + j) * 4 + wc] = s;
            }
        LDS_SYNC();
#pragma unroll
        for (int mt = 0; mt < 4; ++mt)
#pragma unroll
            for (int j = 0; j < 4; ++j) {
                const int i = 64 * wr + 16 * mt + 4 * fq + j;
                const f32x4 rs = *(const LAS f32x4*)(red1 + i * 4);
                const float mu = ((rs[0] + rs[1]) + (rs[2] + rs[3])) * (1.f / HD);
                o[mt][0][j] -= mu; o[mt][1][j] -= mu;
                float s = o[mt][0][j] * o[mt][0][j] + o[mt][1][j] * o[mt][1][j];
                s += __shfl_xor(s, 1); s += __shfl_xor(s, 2); s += __shfl_xor(s, 4); s += __shfl_xor(s, 8);
                if (fr == 0) red2[i * 4 + wc] = s;
            }
        LDS_SYNC();
#pragma unroll
        for (int mt = 0; mt < 4; ++mt)
#pragma unroll
            for (int j = 0; j < 4; ++j) {
                const int i = 64 * wr + 16 * mt + 4 * fq + j;
                const f32x4 rs = *(const LAS f32x4*)(red2 + i * 4);
                const float rstd = rsqrtf(((rs[0] + rs[1]) + (rs[2] + rs[3])) * (1.f / HD) + EPS);
#pragma unroll
                for (int nt = 0; nt < 2; ++nt) {
                    const int dv = 32 * wc + 16 * nt + fr;
                    const float gt = bf2f(GATE[(row0 + i) * RW + h * HD + dv]);
                    MIX[(row0 + i) * D + PW + h * HD + dv] = (bf16_t)f2bf(o[mt][nt][j] * rstd * gt);
                }
                asm volatile("" ::: "memory");
            }
        BLOCK_SYNC();
    }
}

__device__ __forceinline__ void phase_fix(LAS unsigned char* lds, int G, const float* AT, const float* AH, const float* BH, const float* cw, const float* cb, bf16_t* Gb,
                                          const bf16_t* WTfo, const float* mod, float* outy) {
    for (int it = G - 1 - (int)blockIdx.x; it < D / 16; it += G) sample_proj_item(lds, it, Gb, WTfo, DFF, outy + (size_t)MP * D, mod, 5, outy);
    const int total = 64 * 2 * DFF;
    for (int idx = blockIdx.x * 512 + threadIdx.x; idx < total; idx += G * 512) {
        const int pm = idx / (2 * DFF), rem = idx % (2 * DFF), rr = rem / DFF, c = rem % DFF;
        if ((pm & 7) == 0) continue;
        const float a_m1 = rr == 0 ? AT[((size_t)(pm - 1) * 2 + 1) * DFF + c] : AH[((size_t)pm * 2 + 0) * DFF + c];
        const float a_m2 = rr == 0 ? AT[((size_t)(pm - 1) * 2 + 0) * DFF + c] : AT[((size_t)(pm - 1) * 2 + 1) * DFF + c];
        const float a0 = AH[((size_t)pm * 2 + rr) * DFF + c], bb = BH[((size_t)pm * 2 + rr) * DFF + c];
        const float cv = cw[c] * a_m2 + cw[DFF + c] * a_m1 + cw[2 * DFF + c] * a0 + cb[c];
        Gb[((size_t)pm * 256 + rr) * DFF + c] = (bf16_t)f2bf(silu_f(cv) * bb);
    }
}

#define XB_TMO      128
#define XB_XCNT(j)  (256  + 64 * (j))
#define XB_XSUB(j)  (1280 + 64 * (j))
#define XB_XGEN(j)  (2304 + 64 * (j))
#define XB_TOP      3328
#define XB_TOPGEN   3392
#define XCD_BAR_WORDS 3456
#define XB_SPIN_CAP (1u << 18)

__device__ __forceinline__ unsigned xb_ld(unsigned* p)              { return __hip_atomic_load(p, __ATOMIC_RELAXED, __HIP_MEMORY_SCOPE_AGENT); }
__device__ __forceinline__ unsigned xb_add(unsigned* p, unsigned v) { return __hip_atomic_fetch_add(p, v, __ATOMIC_RELAXED, __HIP_MEMORY_SCOPE_AGENT); }
__device__ __forceinline__ unsigned xb_xcc_id() { return (unsigned)__builtin_amdgcn_s_getreg((3 << 11) | 20) & 0xFu; }
#define XB_SPIN(cond, bar) do { unsigned _sp = 0; while (cond) { __builtin_amdgcn_s_sleep(1); \
    if ((++_sp & 255u) == 0u) { if (xb_ld(&(bar)[XB_TMO])) break; if (_sp > XB_SPIN_CAP) { atomicAdd(&(bar)[XB_TMO], 1u); break; } } } } while (0)

struct XcdBarrier {
    unsigned* bar; unsigned x;
    volatile LAS unsigned* st;
};

__device__ __forceinline__ XcdBarrier xcd_barrier_post(unsigned* bar, volatile LAS unsigned* st) {
    XcdBarrier b; b.bar = bar; b.x = xb_xcc_id(); b.st = st;
    if (threadIdx.x == 0) (void)xb_add(&bar[XB_XCNT(b.x)], 1u);
    return b;
}
__device__ __forceinline__ void xcd_barrier_complete(unsigned* bar, unsigned x, unsigned& nloc, unsigned& nx) {
    const unsigned G = gridDim.x * gridDim.y * gridDim.z;
    unsigned sum, cnt, mine, sp = 0u;
    for (;;) {
        sum = 0u; cnt = 0u; mine = 0u;
#pragma unroll
        for (unsigned j = 0; j < 16; ++j) { const unsigned c = xb_ld(&bar[XB_XCNT(j)]); sum += c; cnt += (c > 0u) ? 1u : 0u; mine = (j == x) ? c : mine; }
        if (sum == G) break;
        __builtin_amdgcn_s_sleep(1);
        if ((++sp & 255u) == 0u) { if (xb_ld(&bar[XB_TMO])) break; if (sp > XB_SPIN_CAP) { atomicAdd(&bar[XB_TMO], 1u); break; } }
    }
    nloc = mine > 0u ? mine : 1u; nx = cnt > 0u ? cnt : 1u;
}

__device__ __forceinline__ void xcd_barrier(const XcdBarrier& b) {
    asm volatile("s_waitcnt vmcnt(0)" ::: "memory");
    __syncthreads();
    if (threadIdx.x == 0) {
        unsigned* bar = b.bar;
        __builtin_amdgcn_s_waitcnt(0);
        unsigned nloc = b.st[0], nx = b.st[1];
        if (nloc == 0u) { xcd_barrier_complete(bar, b.x, nloc, nx); b.st[0] = nloc; b.st[1] = nx; }
        const unsigned old = xb_add(&bar[XB_XSUB(b.x)], 1u);
        const unsigned gen = old / nloc;
        if (old + 1u == (gen + 1u) * nloc) {
            __builtin_amdgcn_fence(__ATOMIC_RELEASE, "agent");
            asm volatile("s_waitcnt vmcnt(0)" ::: "memory");
            const unsigned og = xb_add(&bar[XB_TOP], 1u);
            const unsigned tg = og / nx;
            if (og + 1u == (tg + 1u) * nx) xb_add(&bar[XB_TOPGEN], 1u);
            else XB_SPIN(xb_ld(&bar[XB_TOPGEN]) == tg, bar);
            __builtin_amdgcn_fence(__ATOMIC_ACQUIRE, "agent");
            xb_add(&bar[XB_XGEN(b.x)], 1u);
            asm volatile("s_waitcnt vmcnt(0)" ::: "memory");
        } else {
            XB_SPIN(xb_ld(&bar[XB_XGEN(b.x)]) == gen, bar);
            __builtin_amdgcn_fence(__ATOMIC_ACQUIRE, "agent");
            asm volatile("s_waitcnt vmcnt(0)" ::: "memory");
        }
    }
    __syncthreads();
}


struct Args { const float* in[20]; float* out; unsigned char* ws; int ph_lo, ph_hi; };
__global__ void __launch_bounds__(512, 2) hymba_fwd(Args args) {
    extern __shared__ __attribute__((aligned(16))) unsigned char lds_raw[];
    LAS unsigned char* lds = (LAS unsigned char*)lds_raw;
    cg::grid_group grid = cg::this_grid();
    const int G = gridDim.x;
    unsigned char* ws = args.ws; float* out = args.out;
    const float *x_p = args.in[0], *x_s = args.in[1], *c_p = args.in[2], *c_s = args.in[3], *st_pool = args.in[4], *st_ret = args.in[5], *st_conv = args.in[6],
                *g_mix = args.in[7], *g_ffn = args.in[8], *w_ada = args.in[9], *b_ada = args.in[10], *w_in = args.in[11], *w_pool = args.in[12], *ls_pool = args.in[13],
                *w_out = args.in[14], *w_fi = args.in[15], *conv_w = args.in[16], *conv_b = args.in[17], *w_fo = args.in[18], *g_fin = args.in[19];
    float* mod = (float*)(ws + WS_MOD); float* rope = (float*)(ws + WS_ROPE); float* VS = (float*)(ws + WS_VS);
    bf16_t *WTin = (bf16_t*)(ws + WS_WIN), *WTout = (bf16_t*)(ws + WS_WOUT), *WTfi = (bf16_t*)(ws + WS_WFI), *WTfo = (bf16_t*)(ws + WS_WFO);
    float *AT = (float*)(ws + WS_HALO), *AH = AT + HALO_N, *BH = AH + HALO_N;
    bf16_t *RA = (bf16_t*)(ws + WS_RA), *RB = (bf16_t*)(ws + WS_RB), *Ub = (bf16_t*)(ws + WS_U), *GATE = (bf16_t*)(ws + WS_GATE), *Qb = (bf16_t*)(ws + WS_Q), *Kb = (bf16_t*)(ws + WS_K),
           *KT = (bf16_t*)(ws + WS_KT), *VT = (bf16_t*)(ws + WS_VT), *Gb = (bf16_t*)(ws + WS_G);
    bf16_t* SPREV = (bf16_t*)(out + O_YP);
    const int lo = args.ph_lo, hi = args.ph_hi;
#if MK_XCD_BARRIER && !MK_MULTI_LAUNCH
    volatile LAS unsigned* bst = (volatile LAS unsigned*)(lds + LDS_BYTES - 64);
    if (threadIdx.x < 4) bst[threadIdx.x] = 0u;
    __syncthreads();
    XcdBarrier xbar = xcd_barrier_post((unsigned*)(ws + WS_CTL), bst);
#endif
#ifndef PH_MASK
#define PH_MASK 0x7ff
#endif
#define IN(k) (((PH_MASK >> (k)) & 1) && lo <= (k) && (k) < hi)
#if MK_XCD_BARRIER && !MK_MULTI_LAUNCH
#define SEAM(k) do { if (IN(k) && IN((k) + 1)) { if (lo < 0) grid.sync(); else xcd_barrier(xbar); } } while (0)
#define SEAMX() xcd_barrier(xbar)
#else
#define SEAM(k) do { if (IN(k) && IN((k) + 1)) { grid.sync(); } } while (0)
#define SEAMX() grid.sync()
#endif

#ifndef PROBE_REP
#define PROBE_REP (-1)
#endif
#define PHASE(k, ...) do { if (IN(k)) { __VA_ARGS__; if (PROBE_REP == (k)) { SEAMX(); __VA_ARGS__; } } } while (0)
    PHASE(0, phase0(lds, G, c_p, c_s, w_ada, b_ada, w_in, w_out, w_fi, w_fo, mod, rope, WTin, WTout, WTfi, WTfo));
    SEAM(0);
    PHASE(1, norm_phase<0>(G, x_p, x_s, g_mix, mod, 0, 1, RA, nullptr));
    SEAM(1);
    PHASE(2, {
        pg8::Gemm g{RA, WTin, MPAD, INC, D}; pg8::StaticOrder S; S.init(MPAD, INC, G, (int)blockIdx.x);
        EpiIn E{Ub, Qb, Kb, KT, VT, GATE, VS, rope, out};
        pg8::gemm_phase<EpiIn, pg8::StaticOrder, true, true>(lds, g, S, E);
    });
    SEAM(2);
    PHASE(3, phase3(lds, G, Ub, Qb, Kb, KT, VT, GATE, VS, st_pool, st_ret, w_pool, ls_pool, SPREV, RB, out));
    SEAM(3);
    PHASE(4, phase4(lds, G, Qb, Kb, VT, SPREV, GATE, RB, WTout, x_s, mod, out + O_YP));
    SEAM(4);
    PHASE(5, {
        pg8::Gemm g{RB, WTout, MP, D, D}; pg8::StaticOrder S; S.init(MP, D, G, (int)blockIdx.x);
        EpiRes E{x_p, x_s, mod, 2, out + O_YP, 0};
        pg8::gemm_phase<EpiRes, pg8::StaticOrder, true, true>(lds, g, S, E);
    });
    SEAM(5);
    PHASE(6, norm_phase<1>(G, nullptr, nullptr, g_ffn, mod, 3, 4, RA, out + O_YP));
    SEAM(6);
    PHASE(7, {
        pg8::Gemm g{RA, WTfi, MPAD, NFF, D}; pg8::StaticOrder S; S.init(MPAD, NFF, G, (int)blockIdx.x);
        EpiFfn E{Gb, AT, AH, BH, conv_w, conv_b, st_conv, out, (LAS float*)(lds + LDS_X)};
        pg8::gemm_phase<EpiFfn, pg8::StaticOrder, true, true>(lds, g, S, E);
    });
    SEAM(7);
    PHASE(8, phase_fix(lds, G, AT, AH, BH, conv_w, conv_b, Gb, WTfo, mod, out + O_YP));
    SEAM(8);
    PHASE(9, {
        pg8::Gemm g{Gb, WTfo, MP, D, DFF}; pg8::StaticOrder S; S.init(MP, D, G, (int)blockIdx.x);
        EpiRes E{nullptr, nullptr, mod, 5, out + O_YP, 1};
        pg8::gemm_phase<EpiRes, pg8::StaticOrder, true, true>(lds, g, S, E);
    });
    SEAM(9);
    PHASE(10, norm_phase<2>(G, nullptr, nullptr, g_fin, nullptr, 0, 0, nullptr, out + O_YP));
#undef PHASE
#undef IN
#undef SEAM
#undef SEAMX
}

extern "C" void kernel_launch(void* const* d_in, const int* in_sizes, int n_in, void* d_out, int out_size, void* d_ws, size_t ws_size, hipStream_t stream) {
    static int grid = 0;
    if (grid == 0) {
        if (n_in != 20 || (size_t)out_size != O_END || ws_size < WS_END) { fprintf(stderr, "kernel_launch: unexpected problem shape (n_in %d, out %d, ws %zu)\n", n_in, out_size, ws_size); grid = -1; return; }
        int dev = 0, cus = 0, per_cu = 0;
        (void)hipGetDevice(&dev); (void)hipDeviceGetAttribute(&cus, hipDeviceAttributeMultiprocessorCount, dev);
        if (hipFuncSetAttribute((const void*)hymba_fwd, hipFuncAttributeMaxDynamicSharedMemorySize, LDS_BYTES) != hipSuccess) { fprintf(stderr, "kernel_launch: hipFuncSetAttribute failed\n"); grid = -1; return; }
        if (hipOccupancyMaxActiveBlocksPerMultiprocessor(&per_cu, (const void*)hymba_fwd, 512, LDS_BYTES) != hipSuccess || per_cu < 1) per_cu = 1;
        (void)hipGetLastError();
        grid = cus * per_cu;
        if (grid <= 0) grid = 256;
    }
    if (grid < 0) return;
    Args a{};
    for (int i = 0; i < 20; ++i) a.in[i] = (const float*)d_in[i];
    a.out = (float*)d_out; a.ws = (unsigned char*)d_ws;
#if MK_MULTI_LAUNCH
    for (int ph = 0; ph < NPHASE; ++ph) { a.ph_lo = ph; a.ph_hi = ph + 1; hipLaunchKernelGGL(hymba_fwd, dim3(grid), dim3(512), LDS_BYTES, stream, a); }
#else
    a.ph_lo = 0; a.ph_hi = NPHASE;
#if MK_XCD_BARRIER
    (void)hipMemsetAsync((char*)d_ws + WS_CTL, 0, 16384, stream);
#endif
    void* kargs[] = {&a};
    hipError_t e = hipLaunchCooperativeKernel((const void*)hymba_fwd, dim3(grid), dim3(512), kargs, LDS_BYTES, stream);
    if (e != hipSuccess) fprintf(stderr, "kernel_launch: cooperative launch failed: %s (grid %d)\n", hipGetErrorString(e), grid);
#endif
}
```

```cpp
#include <hip/hip_runtime.h>
#include <hip/hip_cooperative_groups.h>
#include <cstdio>
#include <cstdint>
namespace cg = cooperative_groups;

#ifndef MK_MULTI_LAUNCH
#define MK_MULTI_LAUNCH 0
#endif
#ifndef MK_XCD_BARRIER
#define MK_XCD_BARRIER 1
#endif

namespace pg8 {
#define PG8_LAS __attribute__((address_space(3)))
typedef unsigned short bf16_t;
typedef short bf16x8 __attribute__((ext_vector_type(8)));
typedef float f32x4 __attribute__((ext_vector_type(4)));
typedef unsigned u32x4 __attribute__((ext_vector_type(4)));
constexpr int BM = 256, BK = 64, HALF = 128, HTB = HALF * BK * 2  , STAGE_BYTES = 8 * HTB, NXCD = 8, WGM = 8;

__host__ __device__ __forceinline__ int lds_byte(int r, int c) { const int st = (r >> 4) * 2 + (c >> 5), rr = r & 15, cc = c & 31, ob = rr * 64 + cc * 2; return st * 1024 + (ob ^ (((ob >> 9) & 1) << 5)); }
__host__ __device__ __forceinline__ void stage_rc(int b, int& R, int& C) { const int st = b / 1024, sb = b % 1024, swz = sb ^ (((sb >> 9) & 1) << 5); R = (st >> 1) * 16 + swz / 64; C = (st & 1) * 32 + (swz % 64) / 2; }
__host__ __device__ __forceinline__ int perm32(int rho) { const int n = rho >> 4, i = rho & 15; return 8 * (i >> 2) + 4 * n + (i & 3); }

struct Unit { int pm, pn; };
struct Gemm { const bf16_t* A; const bf16_t* Bt; int M, N, K; };

struct StaticOrder {
    int nM, nN, nwg, G, c;
    __host__ __device__ void init(int M, int N, int G_, int c_) { nM = M / BM; nN = N / BM; nwg = nM * nN; G = G_; c = c_; }
    __host__ __device__ bool next(int i, Unit& u) const {
        const long L = (long)i * G + c; if (L >= nwg) return false;
        int wgid = (int)L; { const int q = nwg / NXCD, r = nwg % NXCD, xcd = wgid % NXCD, off = wgid / NXCD; wgid = (xcd < r ? xcd * (q + 1) : r * (q + 1) + (xcd - r) * q) + off; }
        const int nig = WGM * nN, gid = wgid / nig, fm = gid * WGM, gsz = (nM - fm) < WGM ? (nM - fm) : WGM;
        u.pm = fm + ((wgid % nig) % gsz); u.pn = (wgid % nig) / gsz; return true;
    }
    __device__ __forceinline__ void a_ready(const Unit&) const {}
    __device__ __forceinline__ void done(const Unit&) const {}
};

__device__ __forceinline__ unsigned cvt_pk_bf16(float lo, float hi) { unsigned r; asm volatile("v_cvt_pk_bf16_f32 %0, %1, %2" : "=v"(r) : "v"(lo), "v"(hi)); return r; }
template <class Epi, class Sched, bool ALIGN_EPI = false, bool SP2 = false>
__device__ __forceinline__ void gemm_phase(PG8_LAS unsigned char* lds, const Gemm g, const Sched& S, const Epi& E) {
    const int tid = threadIdx.x, wid = __builtin_amdgcn_readfirstlane(tid >> 6), lane = tid & 63, wr = wid >> 2, wc = wid & 3, fr = lane & 15, fq = lane >> 4;
    const int K = g.K, nt = K / BK;
    unsigned voffA[2], voffB[2];
#pragma unroll
    for (int i = 0; i < 2; ++i) { int R, C; stage_rc(tid * 16 + i * 8192, R, C); const int Rb = Epi::PERM ? ((R & ~31) + perm32(R & 31)) : R;
        voffA[i] = (unsigned)(R * K + C) * 2u; voffB[i] = (unsigned)(Rb * K + C) * 2u; }
    const size_t kstep = (size_t)(BK * 2);
    const size_t hstep = (size_t)HALF * K * 2;
    const size_t tstep = 2 * hstep;
    const unsigned ldsw = (unsigned)wid * 1024u;
    const int aoff = lds_byte(wr * 64 + fr, fq * 8), boff = lds_byte(wc * 32 + fr, fq * 8);
#define PG8_SA(b, h) (((b) * 2 + (h)) * HTB)
#define PG8_SB(b, h) ((4 + (b) * 2 + (h)) * HTB)
#define PG8_STAGE(bufoff, gbase, voff) do { _Pragma("unroll") for (int _i = 0; _i < 2; ++_i) \
        __builtin_amdgcn_global_load_lds((const unsigned*)((const char*)(gbase) + (voff)[_i]), (PG8_LAS unsigned*)(lds + (bufoff) + ldsw + _i * 8192), 16, 0, 0); } while (0)
#define PG8_LDA(dst, b, h) do { _Pragma("unroll") for (int m = 0; m < 4; ++m) _Pragma("unroll") for (int k = 0; k < 2; ++k) dst[m][k] = *(const PG8_LAS bf16x8*)(lds + PG8_SA(b, h) + aoff + m * 2048 + k * 1024); } while (0)
#define PG8_LDB(dst, b, h) do { _Pragma("unroll") for (int n = 0; n < 2; ++n) _Pragma("unroll") for (int k = 0; k < 2; ++k) dst[n][k] = *(const PG8_LAS bf16x8*)(lds + PG8_SB(b, h) + boff + n * 2048 + k * 1024); } while (0)
#define PG8_MMA(ai, bj, At, Bt) do { __builtin_amdgcn_s_setprio(1); _Pragma("unroll") for (int m = 0; m < 4; ++m) _Pragma("unroll") for (int n = 0; n < 2; ++n) _Pragma("unroll") for (int k = 0; k < 2; ++k) \
        acc[ai][bj][m][n] = __builtin_amdgcn_mfma_f32_16x16x32_bf16(Bt[n][k], At[m][k], acc[ai][bj][m][n], 0, 0, 0); __builtin_amdgcn_s_setprio(0); } while (0)
#define PG8_WAIT_V(n) asm volatile("s_waitcnt vmcnt(" #n ")" ::: "memory")
#define PG8_WAIT_L(n) asm volatile("s_waitcnt lgkmcnt(" #n ")" ::: "memory")
#define PG8_BAR __builtin_amdgcn_s_barrier()
#define PG8_SCHED __builtin_amdgcn_sched_barrier(0)
    Unit cur, nxt; int ui = 0;
    if (!S.next(0, cur)) return;
    f32x4 acc[2][2][4][2];
#pragma unroll
    for (int a = 0; a < 2; ++a)
#pragma unroll
        for (int b = 0; b < 2; ++b)
#pragma unroll
            for (int m = 0; m < 4; ++m)
#pragma unroll
                for (int n = 0; n < 2; ++n) acc[a][b][m][n] = (f32x4){0.f, 0.f, 0.f, 0.f};
    bf16x8 At[4][2], B0[2][2], B1[2][2];
    const char* cA = (const char*)g.A + (size_t)cur.pm * tstep; const char* cB = (const char*)g.Bt + (size_t)cur.pn * tstep;
    S.a_ready(cur);
    if constexpr (SP2) {
        PG8_STAGE(PG8_SB(0, 0), cB, voffB); PG8_STAGE(PG8_SB(0, 1), cB + hstep, voffB); PG8_STAGE(PG8_SA(0, 0), cA, voffA); PG8_STAGE(PG8_SA(0, 1), cA + hstep, voffA);
        if (wr == 1) PG8_BAR;
        PG8_WAIT_V(2); PG8_BAR;
        PG8_STAGE(PG8_SB(1, 0), cB + kstep, voffB); PG8_STAGE(PG8_SA(1, 0), cA + kstep, voffA); PG8_STAGE(PG8_SB(1, 1), cB + hstep + kstep, voffB);
        PG8_WAIT_V(6); PG8_BAR;
    } else {
        PG8_STAGE(PG8_SB(0, 0), cB, voffB); PG8_STAGE(PG8_SA(0, 0), cA, voffA); PG8_STAGE(PG8_SB(0, 1), cB + hstep, voffB); PG8_STAGE(PG8_SA(0, 1), cA + hstep, voffA);
        if (wr == 1) PG8_BAR;
        PG8_WAIT_V(4); PG8_BAR;
        PG8_STAGE(PG8_SB(1, 0), cB + kstep, voffB); PG8_STAGE(PG8_SA(1, 0), cA + kstep, voffA); PG8_STAGE(PG8_SB(1, 1), cB + hstep + kstep, voffB);
        PG8_WAIT_V(6); PG8_BAR;
    }
    for (;;) {
        const bool has_next = S.next(ui + 1, nxt);
        const char* nA = has_next ? (const char*)g.A + (size_t)nxt.pm * tstep : cA; const char* nB = has_next ? (const char*)g.Bt + (size_t)nxt.pn * tstep : cB;
        for (int t = 0; t < nt; t += 2) {
            const bool last = (t == nt - 2);
            const char* a1 = cA + (size_t)(t + 1) * kstep;
            const char* a2 = last ? nA : cA + (size_t)(t + 2) * kstep; const char* b2 = last ? nB : cB + (size_t)(t + 2) * kstep;
            const char* a3 = a2 + kstep; const char* b3 = b2 + kstep;
            if (last && has_next) S.a_ready(nxt);
            if constexpr (SP2) {
            PG8_LDB(B0, 0, 0); PG8_LDB(B1, 0, 1); PG8_SCHED; PG8_LDA(At, 0, 0); PG8_STAGE(PG8_SA(1, 1), a1 + hstep, voffA);
            PG8_WAIT_V(8); PG8_WAIT_L(0); PG8_BAR; PG8_MMA(0, 0, At, B0); PG8_MMA(0, 1, At, B1); PG8_BAR; PG8_SCHED;
            PG8_LDA(At, 0, 1); PG8_STAGE(PG8_SB(0, 0), b2, voffB); PG8_STAGE(PG8_SB(0, 1), b2 + hstep, voffB); PG8_STAGE(PG8_SA(0, 0), a2, voffA);
            PG8_WAIT_V(8); PG8_WAIT_L(0); PG8_BAR; PG8_MMA(1, 0, At, B0); PG8_MMA(1, 1, At, B1); PG8_BAR; PG8_SCHED;
            PG8_LDB(B0, 1, 0); PG8_LDB(B1, 1, 1); PG8_SCHED; PG8_LDA(At, 1, 0); PG8_STAGE(PG8_SA(0, 1), a2 + hstep, voffA);
            PG8_WAIT_V(8); PG8_WAIT_L(0); PG8_BAR; PG8_MMA(0, 0, At, B0); PG8_MMA(0, 1, At, B1); PG8_BAR; PG8_SCHED;
            PG8_LDA(At, 1, 1); PG8_STAGE(PG8_SB(1, 0), b3, voffB); PG8_STAGE(PG8_SB(1, 1), b3 + hstep, voffB); PG8_STAGE(PG8_SA(1, 0), a3, voffA);
            PG8_WAIT_V(8); PG8_WAIT_L(0); PG8_BAR; PG8_MMA(1, 0, At, B0); PG8_MMA(1, 1, At, B1); PG8_BAR; PG8_SCHED;
            } else {
            PG8_LDB(B0, 0, 0); PG8_SCHED; PG8_LDA(At, 0, 0); PG8_STAGE(PG8_SA(1, 1), a1 + hstep, voffA);
            PG8_WAIT_L(8); PG8_BAR; PG8_WAIT_L(0); PG8_MMA(0, 0, At, B0); PG8_BAR; PG8_SCHED;
            PG8_LDB(B1, 0, 1); PG8_STAGE(PG8_SB(0, 0), b2, voffB);
            PG8_BAR; PG8_WAIT_L(0); PG8_MMA(0, 1, At, B1); PG8_BAR;
            PG8_LDA(At, 0, 1); PG8_STAGE(PG8_SA(0, 0), a2, voffA);
            PG8_BAR; PG8_WAIT_L(0); PG8_MMA(1, 0, At, B0); PG8_BAR; PG8_SCHED;
            PG8_STAGE(PG8_SB(0, 1), b2 + hstep, voffB);
            PG8_WAIT_V(6); PG8_BAR; PG8_MMA(1, 1, At, B1); PG8_BAR;
            PG8_LDB(B0, 1, 0); PG8_SCHED; PG8_LDA(At, 1, 0); PG8_STAGE(PG8_SA(0, 1), a2 + hstep, voffA);
            PG8_WAIT_L(8); PG8_BAR; PG8_WAIT_L(0); PG8_MMA(0, 0, At, B0); PG8_BAR; PG8_SCHED;
            PG8_LDB(B1, 1, 1); PG8_STAGE(PG8_SB(1, 0), b3, voffB);
            PG8_BAR; PG8_WAIT_L(0); PG8_MMA(0, 1, At, B1); PG8_BAR;
            PG8_LDA(At, 1, 1); PG8_STAGE(PG8_SA(1, 0), a3, voffA);
            PG8_BAR; PG8_WAIT_L(0); PG8_MMA(1, 0, At, B0); PG8_BAR; PG8_SCHED;
            PG8_STAGE(PG8_SB(1, 1), b3 + hstep, voffB);
            PG8_WAIT_V(6); PG8_BAR; PG8_MMA(1, 1, At, B1); PG8_BAR;
            }
        }
        if constexpr (ALIGN_EPI) { if (wr == 0) PG8_BAR; }
        if constexpr (!Epi::AFTER_DRAIN) { E(acc, cur, wr, wc, fr, fq); S.done(cur); }
        if (!has_next) break;
#pragma unroll
        for (int a = 0; a < 2; ++a)
#pragma unroll
            for (int b = 0; b < 2; ++b)
#pragma unroll
                for (int m = 0; m < 4; ++m)
#pragma unroll
                    for (int n = 0; n < 2; ++n) acc[a][b][m][n] = (f32x4){0.f, 0.f, 0.f, 0.f};
        cur = nxt; cA = nA; cB = nB; ++ui;
        if constexpr (ALIGN_EPI) { if (wr == 1) PG8_BAR; }
    }
    PG8_WAIT_V(0);
    if constexpr (!ALIGN_EPI) { if (wr == 0) PG8_BAR; }
    PG8_BAR;
    if constexpr (Epi::AFTER_DRAIN) { E.fused(acc, cur, wr, wc, fr, fq, lds, wid, lane); S.done(cur); }
#undef PG8_SA
#undef PG8_SB
#undef PG8_STAGE
#undef PG8_LDA
#undef PG8_LDB
#undef PG8_MMA
#undef PG8_WAIT_V
#undef PG8_WAIT_L
#undef PG8_BAR
#undef PG8_SCHED
}
}

#define LAS __attribute__((address_space(3)))
typedef unsigned short bf16_t;
typedef float f32x4 __attribute__((ext_vector_type(4)));
typedef short bf16x8 __attribute__((ext_vector_type(8)));
typedef unsigned u32x4 __attribute__((ext_vector_type(4)));
typedef unsigned u32x2 __attribute__((ext_vector_type(2)));

constexpr int D = 1024, BP = 8, SEQ = 2048, MP = BP * SEQ, BS = 128, MR = MP + BS, MPAD = 16640;
constexpr int PW = 256, RW = 768, NH = 6, HD = 128, INC = 3328, DFF = 2816, NFF = 5632, NMODC = 6 * D;
constexpr int NCH = SEQ / 128, NBH = BP * NH;
constexpr float EPS = 1e-6f;
constexpr size_t O_YP = 0, O_YS = 16777216, O_PP = 16908288, O_RP = 16939008, O_CP = 17725440, O_PS = 17770496, O_RS = 18262016, O_CS = 30844928, O_END = 31565824;
constexpr size_t MiB = 1u << 20;
constexpr size_t WS_CTL = 0, WS_MOD = 1 * MiB, WS_ROPE = 5 * MiB, WS_VS = 7 * MiB, WS_WIN = 8 * MiB, WS_WOUT = 15 * MiB, WS_WFI = 17 * MiB, WS_WFO = 28 * MiB,
                 WS_HALO = 34 * MiB, WS_RA = 40 * MiB, WS_RB = 73 * MiB, WS_U = 106 * MiB, WS_GATE = 115 * MiB, WS_Q = 140 * MiB, WS_K = 165 * MiB,
                 WS_KT = 190 * MiB, WS_VT = 214 * MiB, WS_G = 140 * MiB, WS_END = 238 * MiB;
constexpr size_t HALO_N = (size_t)65 * 2 * DFF;
constexpr int LDS_BYTES = 147456;
constexpr int LDS_X = 131072;
constexpr int NPHASE = 11;

__device__ __forceinline__ float bf2f(unsigned v) { return __uint_as_float(v << 16); }
__device__ __forceinline__ unsigned f2bf(float f) { unsigned u = __float_as_uint(f); return (u + 0x7fffu + ((u >> 16) & 1u)) >> 16; }
__device__ __forceinline__ unsigned pk2(float lo, float hi) { return pg8::cvt_pk_bf16(lo, hi); }
__device__ __forceinline__ float silu_f(float x) { return x / (1.f + __expf(-x)); }
__device__ __forceinline__ float wave_sum(float v) {
#pragma unroll
    for (int o = 1; o < 64; o <<= 1) v += __shfl_xor(v, o);
    return v;
}
__device__ __forceinline__ float lg2_gamma(int h) { return log2f(1.0f - exp2f(-5.0f - (float)h)); }
__device__ __forceinline__ f32x4 mfma16(bf16x8 a, bf16x8 b, f32x4 c) { return __builtin_amdgcn_mfma_f32_16x16x32_bf16(a, b, c, 0, 0, 0); }
#define BLOCK_SYNC() do { asm volatile("s_waitcnt vmcnt(0) lgkmcnt(0)" ::: "memory"); __builtin_amdgcn_s_barrier(); asm volatile("" ::: "memory"); } while (0)
#define LDS_SYNC() do { asm volatile("s_waitcnt lgkmcnt(0)" ::: "memory"); __builtin_amdgcn_s_barrier(); asm volatile("" ::: "memory"); } while (0)

template <int MAP> __device__ __forceinline__ int wrow_map(int c) {
    if (MAP == 1) return (c & ~127) | (32 * ((c & 63) >> 4) + 16 * ((c & 127) >> 6) + (c & 15));
    if (MAP == 2) { const int a = c < DFF ? c : c - DFF; return 256 * (a >> 7) + (c < DFF ? 0 : 128) + (a & 127); }
    return c;
}
template <int MAP> __device__ __forceinline__ void p0_transpose_item(const float* __restrict__ W, int K, int N, bf16_t* __restrict__ WT, LAS float* scr, int item, int lane) {
    const int nblk = N / 32, kb = item / nblk, nb = item % nblk, k0 = 64 * kb, n0 = 32 * nb;
#pragma unroll 8
    for (int i = 0; i < 32; ++i) { const int kk = 2 * i + (lane >> 5); scr[kk * 33 + (lane & 31)] = W[(size_t)(k0 + kk) * N + n0 + (lane & 31)]; }
    asm volatile("s_waitcnt lgkmcnt(0)" ::: "memory");
    const int c = lane & 7;
#pragma unroll
    for (int j = 0; j < 4; ++j) { const int n = (lane >> 3) + 8 * j; const LAS float* s = scr + (8 * c) * 33 + n;
        u32x4 o; o.x = pk2(s[0 * 33], s[1 * 33]); o.y = pk2(s[2 * 33], s[3 * 33]); o.z = pk2(s[4 * 33], s[5 * 33]); o.w = pk2(s[6 * 33], s[7 * 33]);
        *(u32x4*)(WT + (size_t)wrow_map<MAP>(n0 + n) * K + k0 + 8 * c) = o; }
    asm volatile("s_waitcnt lgkmcnt(0)" ::: "memory");
}

__device__ __forceinline__ void phase0(LAS unsigned char* lds, int G, const float* c_p, const float* c_s, const float* w_ada, const float* b_ada,
                                       const float* w_in, const float* w_out, const float* w_fi, const float* w_fo,
                                       float* mod, float* rope, bf16_t* WTin, bf16_t* WTout, bf16_t* WTfi, bf16_t* WTfo) {
    const int tid = threadIdx.x, lane = tid & 63, w = __builtin_amdgcn_readfirstlane(tid >> 6), fr = lane & 15, fq = lane >> 4;
    LAS float* red = (LAS float*)lds;
    for (int it = blockIdx.x; it < NMODC / 32; it += G) {
        const int n0 = it * 32;
        f32x4 acc[9][2];
#pragma unroll
        for (int mt = 0; mt < 9; ++mt) { acc[mt][0] = (f32x4){0.f, 0.f, 0.f, 0.f}; acc[mt][1] = (f32x4){0.f, 0.f, 0.f, 0.f}; }
#pragma unroll 1
        for (int ks = 0; ks < 4; ++ks) {
            const int k0 = 128 * w + 32 * ks + fq * 8;
            bf16x8 bfr[2];
#pragma unroll
            for (int nt = 0; nt < 2; ++nt) {
                const float* wp = w_ada + (size_t)k0 * NMODC + n0 + 16 * nt + fr;
                float t[8];
#pragma unroll
                for (int j = 0; j < 8; ++j) t[j] = wp[(size_t)j * NMODC];
                u32x4 pk; pk.x = pk2(t[0], t[1]); pk.y = pk2(t[2], t[3]); pk.z = pk2(t[4], t[5]); pk.w = pk2(t[6], t[7]);
                bfr[nt] = __builtin_bit_cast(bf16x8, pk);
            }
#pragma unroll
            for (int mt = 0; mt < 9; ++mt) {
                const int row = 16 * mt + fr;
                u32x4 pk = (u32x4){0u, 0u, 0u, 0u};
                if (row < BP + BS) {
                    const float* cp = (row < BP ? c_p + (size_t)row * D : c_s + (size_t)(row - BP) * D) + k0;
                    const f32x4 a0 = *(const f32x4*)cp, a1 = *(const f32x4*)(cp + 4);
                    pk.x = pk2(silu_f(a0[0]), silu_f(a0[1])); pk.y = pk2(silu_f(a0[2]), silu_f(a0[3]));
                    pk.z = pk2(silu_f(a1[0]), silu_f(a1[1])); pk.w = pk2(silu_f(a1[2]), silu_f(a1[3]));
                }
                const bf16x8 afr = __builtin_bit_cast(bf16x8, pk);
                acc[mt][0] = mfma16(afr, bfr[0], acc[mt][0]);
                acc[mt][1] = mfma16(afr, bfr[1], acc[mt][1]);
            }
        }
#pragma unroll 1
        for (int r = 0; r < 8; ++r) {
            if (w == r) {
#pragma unroll
                for (int mt = 0; mt < 9; ++mt)
#pragma unroll
                    for (int nt = 0; nt < 2; ++nt)
#pragma unroll
                        for (int j = 0; j < 4; ++j) { const int idx = (16 * mt + 4 * fq + j) * 32 + 16 * nt + fr; red[idx] = (r == 0 ? 0.f : red[idx]) + acc[mt][nt][j]; }
            }
            LDS_SYNC();
        }
        for (int idx = tid; idx < (BP + BS) * 32; idx += 512) { const int row = idx >> 5, c = idx & 31; mod[(size_t)row * NMODC + n0 + c] = red[idx] + b_ada[n0 + c]; }
        LDS_SYNC();
    }
    {
        LAS float* scr = (LAS float*)(lds + w * 16384);
        const int gw = blockIdx.x * 8 + w, NGW = G * 8;
        constexpr int I_IN = (D / 64) * (INC / 32), I_OUT = (D / 64) * (D / 32), I_FI = (D / 64) * (NFF / 32), I_FO = (DFF / 64) * (D / 32);
        constexpr int NITEMS = I_IN + I_OUT + I_FI + I_FO;
        for (int it = NITEMS - 1 - gw; it >= 0; it -= NGW) {
            int r = it;
            if (r < I_IN) { p0_transpose_item<1>(w_in, D, INC, WTin, scr, r, lane); continue; } r -= I_IN;
            if (r < I_OUT) { p0_transpose_item<0>(w_out, D, D, WTout, scr, r, lane); continue; } r -= I_OUT;
            if (r < I_FI) { p0_transpose_item<2>(w_fi, D, NFF, WTfi, scr, r, lane); continue; } r -= I_FI;
            p0_transpose_item<0>(w_fo, DFF, D, WTfo, scr, r, lane);
        }
    }
    for (int idx = blockIdx.x * 512 + tid; idx < (SEQ + 1) * 64; idx += G * 512) {
        const int ps = idx >> 6, i = idx & 63;
        const double pos = ps == SEQ ? 16384.0 : (double)ps;
        const double inv = exp(-(double)i * (9.210340371976184 / 64.0));
        double s, c; sincos(pos * inv, &s, &c);
        rope[(size_t)ps * 128 + i] = (float)c; rope[(size_t)ps * 128 + 64 + i] = (float)s;
    }
}

template <int MODE> __device__ __forceinline__ void norm_phase(int G, const float* xp, const float* xs, const float* gvec, const float* mod, int sh_i, int sc_i, bf16_t* H, float* outy) {
    const int tid = threadIdx.x, lane = tid & 63, w = tid >> 6;
    const int gw = blockIdx.x * 8 + w, NGW = G * 8;
    const int nrows = MODE == 2 ? MR : MPAD;
    for (int r = gw; r < nrows; r += NGW) {
        if (MODE != 2 && r >= MR) {
            u32x2* o = (u32x2*)(H + (size_t)r * D) + lane;
#pragma unroll
            for (int j = 0; j < 4; ++j) o[64 * j] = (u32x2){0u, 0u};
            continue;
        }
        const float* src = MODE == 0 ? (r < MP ? xp + (size_t)r * D : xs + (size_t)(r - MP) * D) : outy + (size_t)r * D;
        const f32x4* xr = (const f32x4*)src + lane;
        f32x4 v[4]; float ss = 0.f;
#pragma unroll
        for (int j = 0; j < 4; ++j) { v[j] = xr[64 * j]; ss += (v[j][0] * v[j][0] + v[j][1] * v[j][1]) + (v[j][2] * v[j][2] + v[j][3] * v[j][3]); }
        const float rstd = rsqrtf(wave_sum(ss) * (1.f / D) + EPS);
        if (MODE == 2) {
            f32x4* o = (f32x4*)(outy + (size_t)r * D) + lane;
#pragma unroll
            for (int j = 0; j < 4; ++j) { const f32x4 g4 = ((const f32x4*)gvec)[lane + 64 * j]; o[64 * j] = v[j] * rstd * g4; }
        } else {
            const int nb = r < MP ? (r >> 11) : BP + (r - MP);
            const f32x4* scp = (const f32x4*)(mod + (size_t)nb * NMODC + sc_i * D) + lane;
            const f32x4* shp = (const f32x4*)(mod + (size_t)nb * NMODC + sh_i * D) + lane;
            u32x2* o = (u32x2*)(H + (size_t)r * D) + lane;
#pragma unroll
            for (int j = 0; j < 4; ++j) { const f32x4 g4 = ((const f32x4*)gvec)[lane + 64 * j], sc = scp[64 * j], sh = shp[64 * j];
                const f32x4 y = v[j] * rstd * g4 * (sc + 1.0f) + sh;
                o[64 * j] = (u32x2){pk2(y[0], y[1]), pk2(y[2], y[3])}; }
        }
    }
}

struct EpiIn {
    static constexpr bool PERM = false, AFTER_DRAIN = false;
    bf16_t *U, *Q, *Kb, *KT, *VT, *GATE; float* VS; const float* rope; float* out;
    __device__ __forceinline__ void operator()(const f32x4 (&acc)[2][2][4][2], const pg8::Unit& u, int wr, int wc, int fr, int fq) const {
        asm volatile("" : "+v"(fr), "+v"(fq));
        const int p0 = 16 * wc + 4 * fq;
#pragma unroll
        for (int bj = 0; bj < 2; ++bj) {
            const int blk = 2 * u.pn + bj;
            const int region = blk < 2 ? 0 : 1 + (blk - 2) / NH, h = blk < 2 ? blk : (blk - 2) % NH;
            const float lg = lg2_gamma(h);
#pragma unroll
            for (int ai = 0; ai < 2; ++ai) {
                f32x4 rc[4], rs[4];
                if (region == 1 || region == 2) {
#pragma unroll
                    for (int m = 0; m < 4; ++m) {
                        const int r = u.pm * 256 + ai * 128 + wr * 64 + m * 16 + fr;
                        const float* cs = rope + (size_t)(r >= MP ? SEQ : (r & (SEQ - 1))) * 128 + p0;
                        rc[m] = *(const f32x4*)cs; rs[m] = *(const f32x4*)(cs + 64);
                    }
                }
#pragma unroll
                for (int m = 0; m < 4; ++m) {
                    const int r = u.pm * 256 + ai * 128 + wr * 64 + m * 16 + fr;
                    if (r >= MR) continue;
                    const bool samp = r >= MP; const int b = r >> 11, t = r & (SEQ - 1), bs = r - MP;
                    const f32x4 v0 = acc[ai][bj][m][0], v1 = acc[ai][bj][m][1];
                    if (region == 0) {
                        const int c0 = 128 * h + p0;
                        *(u32x2*)(U + (size_t)r * PW + c0) = (u32x2){pk2(v0[0], v0[1]), pk2(v0[2], v0[3])};
                        *(u32x2*)(U + (size_t)r * PW + c0 + 64) = (u32x2){pk2(v1[0], v1[1]), pk2(v1[2], v1[3])};
                        if (samp) { float* o = out + O_PS + ((size_t)bs * 15 + 14) * PW + c0; *(f32x4*)o = v0; *(f32x4*)(o + 64) = v1; }
                        else if (t >= SEQ - 15) { float* o = out + O_PP + ((size_t)b * 15 + (t - (SEQ - 15))) * PW + c0; *(f32x4*)o = v0; *(f32x4*)(o + 64) = v1; }
                    } else if (region == 1 || region == 2) {
                        const f32x4 c4 = rc[m], s4 = rs[m];
                        f32x4 o1 = v0 * c4 - v1 * s4, o2 = v0 * s4 + v1 * c4;
                        if (region == 2) { o1 = o1 * 0.08838834764831845f; o2 = o2 * 0.08838834764831845f; }
                        bf16_t* dst = (region == 1 ? Q : Kb) + (size_t)r * RW + h * HD + p0;
                        *(u32x2*)dst = (u32x2){pk2(o1[0], o1[1]), pk2(o1[2], o1[3])};
                        *(u32x2*)(dst + 64) = (u32x2){pk2(o2[0], o2[1]), pk2(o2[2], o2[3])};
                        if (region == 2 && !samp) {
                            const float kd = exp2f((float)(127 - (t & 127)) * lg);
                            bf16_t* kt = KT + ((size_t)(b * NH + h) * HD + p0) * SEQ + t;
#pragma unroll
                            for (int e = 0; e < 4; ++e) { kt[(size_t)e * SEQ] = (bf16_t)f2bf(o1[e] * kd); kt[(size_t)(64 + e) * SEQ] = (bf16_t)f2bf(o2[e] * kd); }
                        }
                    } else if (region == 3) {
                        if (samp) { float* o = VS + (size_t)bs * RW + h * HD + p0; *(f32x4*)o = v0; *(f32x4*)(o + 64) = v1; }
                        else {
                            bf16_t* vt = VT + ((size_t)(b * NH + h) * HD + p0) * SEQ + t;
#pragma unroll
                            for (int e = 0; e < 4; ++e) { vt[(size_t)e * SEQ] = (bf16_t)f2bf(v0[e]); vt[(size_t)(64 + e) * SEQ] = (bf16_t)f2bf(v1[e]); }
                        }
                    } else {
                        bf16_t* dst = GATE + (size_t)r * RW + h * HD + p0;
                        *(u32x2*)dst = (u32x2){pk2(silu_f(v0[0]), silu_f(v0[1])), pk2(silu_f(v0[2]), silu_f(v0[3]))};
                        *(u32x2*)(dst + 64) = (u32x2){pk2(silu_f(v1[0]), silu_f(v1[1])), pk2(silu_f(v1[2]), silu_f(v1[3]))};
                    }
                }
            }
        }
    }
};
struct EpiRes {
    static constexpr bool PERM = false, AFTER_DRAIN = false;
    const float *xp, *xs; const float* mod; int gate_i; float* outy; int from_out;
    __device__ __forceinline__ void operator()(const f32x4 (&acc)[2][2][4][2], const pg8::Unit& u, int wr, int wc, int fr, int fq) const {
        asm volatile("" : "+v"(fr), "+v"(fq));
        const int c0 = u.pn * 256 + wc * 32 + fq * 4;
        const int nb = u.pm >> 3;
        const float* gp = mod + (size_t)nb * NMODC + gate_i * D + c0;
        f32x4 gv[2][2];
#pragma unroll
        for (int bj = 0; bj < 2; ++bj)
#pragma unroll
            for (int n = 0; n < 2; ++n) gv[bj][n] = *(const f32x4*)(gp + bj * 128 + n * 16);
#pragma unroll
        for (int ai = 0; ai < 2; ++ai)
#pragma unroll
            for (int mh = 0; mh < 2; ++mh) {
                f32x4 bv[2][2][2];
#pragma unroll
                for (int m2 = 0; m2 < 2; ++m2) {
                    const size_t r = (size_t)(u.pm * 256 + ai * 128 + wr * 64 + (mh * 2 + m2) * 16 + fr);
                    const float* base = (from_out ? outy : xp) + r * D + c0;
#pragma unroll
                    for (int bj = 0; bj < 2; ++bj)
#pragma unroll
                        for (int n = 0; n < 2; ++n) bv[m2][bj][n] = *(const f32x4*)(base + bj * 128 + n * 16);
                }
#pragma unroll
                for (int m2 = 0; m2 < 2; ++m2) {
                    const size_t r = (size_t)(u.pm * 256 + ai * 128 + wr * 64 + (mh * 2 + m2) * 16 + fr);
#pragma unroll
                    for (int bj = 0; bj < 2; ++bj)
#pragma unroll
                        for (int n = 0; n < 2; ++n) *(f32x4*)(outy + r * D + c0 + bj * 128 + n * 16) = bv[m2][bj][n] + gv[bj][n] * acc[ai][bj][mh * 2 + m2][n];
                }
            }
    }
};
struct EpiFfn {
    static constexpr bool PERM = false, AFTER_DRAIN = false;
    bf16_t* Gb; float *AT, *AH, *BH; const float *cw, *cb, *sconv; float* out; LAS float* tail;
    __device__ __forceinline__ void operator()(const f32x4 (&acc)[2][2][4][2], const pg8::Unit& u, int wr, int wc, int fr, int fq) const {
        asm volatile("" : "+v"(fr), "+v"(fq));
        const int lane = fq * 16 + fr, pm = u.pm;
        int ca[2];
#pragma unroll
        for (int n = 0; n < 2; ++n) ca[n] = 128 * u.pn + 32 * wc + 16 * n + 4 * fq;
        if (pm == MP / 256) {
#pragma unroll
            for (int m = 0; m < 4; ++m)
#pragma unroll
                for (int n = 0; n < 2; ++n) {
                    const int bs = wr * 64 + m * 16 + fr;
                    const f32x4 a = acc[0][0][m][n], bb = acc[0][1][m][n];
                    const f32x4 s0 = *(const f32x4*)(sconv + ((size_t)bs * 2 + 0) * DFF + ca[n]), s1 = *(const f32x4*)(sconv + ((size_t)bs * 2 + 1) * DFF + ca[n]);
                    const f32x4 w0 = *(const f32x4*)(cw + ca[n]), w1 = *(const f32x4*)(cw + DFF + ca[n]), w2 = *(const f32x4*)(cw + 2 * DFF + ca[n]), cbv = *(const f32x4*)(cb + ca[n]);
                    const f32x4 cv = w0 * s0 + w1 * s1 + w2 * a + cbv;
                    f32x4 g;
#pragma unroll
                    for (int e = 0; e < 4; ++e) g[e] = silu_f(cv[e]) * bb[e];
                    *(u32x2*)(Gb + (size_t)(MP + bs) * DFF + ca[n]) = (u32x2){pk2(g[0], g[1]), pk2(g[2], g[3])};
                    *(f32x4*)(out + O_CS + ((size_t)bs * 2 + 0) * DFF + ca[n]) = s1;
                    *(f32x4*)(out + O_CS + ((size_t)bs * 2 + 1) * DFF + ca[n]) = a;
                }
            return;
        }
        if (fr >= 14) {
#pragma unroll
            for (int ai = 0; ai < 2; ++ai)
#pragma unroll
                for (int n = 0; n < 2; ++n) {
                    const f32x4 v = acc[ai][0][3][n];
                    *(LAS f32x4*)(tail + (((ai * 2 + wr) * 4 + wc) * 2 + (fr - 14)) * 32 + 16 * n + 4 * fq) = v;
                    if (ai == 1 && wr == 1) {
                        *(f32x4*)(AT + ((size_t)pm * 2 + (fr - 14)) * DFF + ca[n]) = v;
                        if ((pm & 7) == 7) *(f32x4*)(out + O_CP + ((size_t)(pm >> 3) * 2 + (fr - 14)) * DFF + ca[n]) = v;
                    }
                }
        }
        LDS_SYNC();
#pragma unroll
        for (int n = 0; n < 2; ++n) {
            const int can = 128 * u.pn + 32 * wc + 16 * n + 4 * fq;
            const f32x4 w0 = *(const f32x4*)(cw + can), w1 = *(const f32x4*)(cw + DFF + can), w2 = *(const f32x4*)(cw + 2 * DFF + can), cbv = *(const f32x4*)(cb + can);
#pragma unroll
            for (int ai = 0; ai < 2; ++ai) {
                const int s = ai * 2 + wr;
                f32x4 prev = (f32x4){0.f, 0.f, 0.f, 0.f};
                if (s > 0 && fr >= 14) prev = *(const LAS f32x4*)(tail + ((((s - 1) * 4) + wc) * 2 + (fr - 14)) * 32 + 16 * n + 4 * fq);
#pragma unroll
                for (int m = 0; m < 4; ++m) {
                    const int r = pm * 256 + ai * 128 + wr * 64 + m * 16 + fr;
                    const bool top = (s == 0 && m == 0 && fr < 2 && (pm & 7) != 0);
                    const f32x4 cur = acc[ai][0][m][n], bb = acc[ai][1][m][n];
                    f32x4 g;
#pragma unroll
                    for (int e = 0; e < 4; ++e) {
                        const float c1 = __shfl(cur[e], lane - 1), c2 = __shfl(cur[e], lane - 2), q1 = __shfl(prev[e], lane + 15), q2 = __shfl(prev[e], lane + 14);
                        const float a1 = fr >= 1 ? c1 : q1, a2 = fr >= 2 ? c2 : q2;
                        g[e] = silu_f(w0[e] * a2 + w1[e] * a1 + w2[e] * cur[e] + cbv[e]) * bb[e];
                    }
                    if (top) { *(f32x4*)(AH + ((size_t)pm * 2 + fr) * DFF + can) = cur; *(f32x4*)(BH + ((size_t)pm * 2 + fr) * DFF + can) = bb; }
                    else *(u32x2*)(Gb + (size_t)r * DFF + can) = (u32x2){pk2(g[0], g[1]), pk2(g[2], g[3])};
                    prev = cur;
                    asm volatile("" ::: "memory");
                }
            }
        }
    }
};

__device__ __forceinline__ void phase3(LAS unsigned char* lds, int G, const bf16_t* U, const bf16_t* Q, const bf16_t* Kb, const bf16_t* KT, const bf16_t* VT, const bf16_t* GATE,
                                       const float* VS, const float* state_pool, const float* state_ret, const float* w_pool, const float* ls_pool,
                                       bf16_t* SPREV, bf16_t* MIX, float* out, int sel) {
    const int tid = threadIdx.x, lane = tid & 63, w = __builtin_amdgcn_readfirstlane(tid >> 6);
    const int vcu = (G % 8 == 0) ? ((int)blockIdx.x % 8) * (G / 8) + (int)blockIdx.x / 8 : (int)blockIdx.x;
    if (sel == 0 || sel == 1)
    for (int it = vcu; it < NBH * 16; it += G) {
        const int bh = it >> 4, dv0 = 32 * ((it >> 2) & 3), dk0 = 32 * (it & 3), h = bh % NH;
        int lf = lane; asm volatile("" : "+v"(lf));
        const int fr = lf & 15, fq = lf >> 4;
        const float gC = exp2f(128.f * lg2_gamma(h));
        LAS float* kv = (LAS float*)lds;
        const bf16_t* vt = VT + ((size_t)bh * HD + dv0 + fr) * SEQ + (2 * w) * 128 + fq * 8;
        const bf16_t* kt = KT + ((size_t)bh * HD + dk0 + fr) * SEQ + (2 * w) * 128 + fq * 8;
        bf16x8 Af[2][2][4], Bf[2][2][4];
#pragma unroll
        for (int ci = 0; ci < 2; ++ci)
#pragma unroll
            for (int mt = 0; mt < 2; ++mt)
#pragma unroll
                for (int ks = 0; ks < 4; ++ks) { Af[ci][mt][ks] = *(const bf16x8*)(vt + (size_t)(16 * mt) * SEQ + ci * 128 + ks * 32); Bf[ci][mt][ks] = *(const bf16x8*)(kt + (size_t)(16 * mt) * SEQ + ci * 128 + ks * 32); }
#pragma unroll
        for (int ci = 0; ci < 2; ++ci)
#pragma unroll
            for (int nt = 0; nt < 2; ++nt)
#pragma unroll
                for (int mt = 0; mt < 2; ++mt) {
                    f32x4 a = (f32x4){0.f, 0.f, 0.f, 0.f};
#pragma unroll
                    for (int ks = 0; ks < 4; ++ks) a = mfma16(Bf[ci][nt][ks], Af[ci][mt][ks], a);
                    *(LAS f32x4*)(kv + ((2 * w + ci) * 32 + 16 * mt + fr) * 36 + 16 * nt + 4 * fq) = a;
                }
        LDS_SYNC();
        {
            const int dv = tid >> 4, dk2 = (tid & 15) * 2;
            float s0 = 0.f, s1 = 0.f;
            bf16_t* sp = SPREV + (((size_t)bh * NCH) * HD + dv0 + dv) * HD + dk0 + dk2;
#pragma unroll 4
            for (int c = 0; c < NCH; ++c) {
                *(unsigned*)(sp + (size_t)c * HD * HD) = pk2(s0, s1);
                const LAS float* kp = kv + (c * 32 + dv) * 36 + dk2;
                s0 = s0 * gC + kp[0]; s1 = s1 * gC + kp[1];
            }
            float* o = out + O_RP + ((size_t)bh * HD + dk0 + dk2) * HD + dv0 + dv;
            o[0] = s0; o[HD] = s1;
        }
        LDS_SYNC();
    }
    if (sel == 0 || sel == 2)
    for (int id = blockIdx.x; id < BS * NH; id += G) {
        const int bs = id / NH, h = id % NH, row = MP + bs;
        const float gam = 1.0f - exp2f(-5.0f - (float)h);
        LAS float* red = (LAS float*)lds;
        LAS float* qv = red + 16 * 128;
        const int dkg = tid >> 5, c4 = tid & 31;
        const float* s0p = state_ret + (((size_t)bs * NH + h) * HD + dkg * 8) * HD + 4 * c4;
        f32x4 sv[8];
#pragma unroll
        for (int i = 0; i < 8; ++i) sv[i] = *(const f32x4*)(s0p + (size_t)i * HD);
        const f32x4 v4 = *(const f32x4*)(VS + (size_t)bs * RW + h * HD + 4 * c4);
        if (tid < 256) { const int i = tid & 127; qv[tid] = bf2f((tid < 128 ? Q : Kb)[(size_t)row * RW + h * HD + i]); }
        float vsl[2] = {0.f, 0.f}, gtl[2] = {0.f, 0.f};
        if (w == 0) {
#pragma unroll
            for (int i = 0; i < 2; ++i) { vsl[i] = VS[(size_t)bs * RW + h * HD + lane + 64 * i]; gtl[i] = bf2f(GATE[(size_t)row * RW + h * HD + lane + 64 * i]); }
        }
        LDS_SYNC();
        float* sn = out + O_RS + (((size_t)bs * NH + h) * HD + dkg * 8) * HD + 4 * c4;
        f32x4 part = (f32x4){0.f, 0.f, 0.f, 0.f};
#pragma unroll
        for (int i = 0; i < 8; ++i) {
            const float qd = qv[dkg * 8 + i], kd = qv[128 + dkg * 8 + i];
            part = part + sv[i] * qd;
            *(f32x4*)(sn + (size_t)i * HD) = sv[i] * gam + v4 * kd;
        }
        *(LAS f32x4*)(red + dkg * 128 + 4 * c4) = part;
        LDS_SYNC();
        if (w == 0) {
            float qk = 0.f;
#pragma unroll
            for (int i = 0; i < 2; ++i) qk += qv[lane + 64 * i] * qv[128 + lane + 64 * i];
            qk = wave_sum(qk);
            float o[2], s1 = 0.f;
#pragma unroll
            for (int i = 0; i < 2; ++i) { const int dv = lane + 64 * i; float a = 0.f;
#pragma unroll
                for (int g = 0; g < 16; ++g) a += red[g * 128 + dv];
                o[i] = qk * vsl[i] + gam * a; s1 += o[i]; }
            const float mu = wave_sum(s1) * (1.f / HD);
            float s2 = 0.f;
#pragma unroll
            for (int i = 0; i < 2; ++i) { o[i] -= mu; s2 += o[i] * o[i]; }
            const float rstd = rsqrtf(wave_sum(s2) * (1.f / HD) + EPS);
#pragma unroll
            for (int i = 0; i < 2; ++i) MIX[(size_t)row * D + PW + h * HD + lane + 64 * i] = (bf16_t)f2bf(o[i] * rstd * gtl[i]);
        }
        LDS_SYNC();
    }
    if (sel == 0 || sel == 3) {
        const int d = tid & 63, g = (tid >> 6) & 3, half = tid >> 8;
        float wc[64];
#pragma unroll
        for (int c = 0; c < 64; ++c) wc[c] = w_pool[(size_t)(g * 64 + c) * 64 + d];
        const float ls = ls_pool[g * 64 + d];
        LAS float* ub = (LAS float*)lds;
        LAS float* pb = ub + 47 * 256;
        for (int it = blockIdx.x; it < MP / 32 + BS / 8; it += G) {
            int ntok, row0;
            if (it < MP / 32) {
                const int r0 = it * 32, t0 = r0 & (SEQ - 1);
                ntok = 32; row0 = r0;
                u32x4 raw[3];
#pragma unroll
                for (int i = 0; i < 3; ++i) { const int idx = tid + 512 * i, rr = idx >> 5, c8 = idx & 31; raw[i] = (u32x4){0u, 0u, 0u, 0u};
                    if (idx < 47 * 32 && t0 - 15 + rr >= 0) raw[i] = *(const u32x4*)(U + (size_t)(r0 - 15 + rr) * PW + c8 * 8); }
#pragma unroll
                for (int i = 0; i < 3; ++i) { const int idx = tid + 512 * i, rr = idx >> 5, c8 = idx & 31;
                    if (idx < 47 * 32) { LAS f32x4* dst = (LAS f32x4*)(ub + rr * 256 + c8 * 8);
                        dst[0] = (f32x4){bf2f(raw[i].x & 0xffffu), bf2f(raw[i].x >> 16), bf2f(raw[i].y & 0xffffu), bf2f(raw[i].y >> 16)};
                        dst[1] = (f32x4){bf2f(raw[i].z & 0xffffu), bf2f(raw[i].z >> 16), bf2f(raw[i].w & 0xffffu), bf2f(raw[i].w >> 16)}; } }
                LDS_SYNC();
                { const int ch = tid & 255, gg = ch >> 6, wn = 2 << gg;
#pragma unroll 1
                  for (int i = 0; i < 16; ++i) { const int tt = (tid >> 8) * 16 + i; float s = 0.f;
                      for (int k = 0; k < wn; ++k) s += ub[(15 + tt - k) * 256 + ch];
                      const int cnt = min(wn, t0 + tt + 1);
                      pb[tt * 256 + ch] = s / (float)cnt - ub[(15 + tt) * 256 + ch]; } }
            } else {
                const int s0i = (it - MP / 32) * 8;
                ntok = 8; row0 = MP + s0i;
                const int sidx = tid >> 6, c4 = tid & 63, bs = s0i + sidx, wn = 2 << (c4 >> 4);
                f32x4 hv[15];
#pragma unroll
                for (int j = 0; j < 15; ++j) hv[j] = *(const f32x4*)(state_pool + ((size_t)bs * 15 + j) * PW + 4 * c4);
                const u32x2 ur = *(const u32x2*)(U + (size_t)(MP + bs) * PW + 4 * c4);
                const f32x4 un = (f32x4){bf2f(ur.x & 0xffffu), bf2f(ur.x >> 16), bf2f(ur.y & 0xffffu), bf2f(ur.y >> 16)};
                f32x4 sm = un;
#pragma unroll
                for (int j = 0; j < 15; ++j) { if (j >= 16 - wn) sm = sm + hv[j];
                    if (j >= 1) *(f32x4*)(out + O_PS + ((size_t)bs * 15 + j - 1) * PW + 4 * c4) = hv[j]; }
                *(LAS f32x4*)(pb + sidx * 256 + 4 * c4) = sm * (1.0f / (float)wn) - un;
            }
            LDS_SYNC();
            const int per = ntok >> 1;
            for (int tt = half * per; tt < (half + 1) * per; ++tt) {
                const LAS f32x4* pp = (const LAS f32x4*)(pb + tt * 256 + g * 64);
                float y = 0.f;
#pragma unroll
                for (int c4 = 0; c4 < 16; ++c4) { const f32x4 p4 = pp[c4]; y += p4[0] * wc[4 * c4] + p4[1] * wc[4 * c4 + 1] + p4[2] * wc[4 * c4 + 2] + p4[3] * wc[4 * c4 + 3]; }
                MIX[(size_t)(row0 + tt) * D + g * 64 + d] = (bf16_t)f2bf(y * ls);
            }
            LDS_SYNC();
        }
    }
}

template <int K> __device__ __forceinline__ void sample_proj_item(LAS unsigned char* lds, int item, const bf16_t* A, const bf16_t* Bt, const float* base, const float* mod, int gate_i, float* outy) {
    constexpr int KS = K / 8, NST = KS / 32, NB = 6;
    const int tid = threadIdx.x, w = __builtin_amdgcn_readfirstlane(tid >> 6);
    int lf = tid & 63; asm volatile("" : "+v"(lf));
    const int fr = lf & 15, fq = lf >> 4;
    const int n0 = (item >> 1) * 16, m0 = (item & 1) * 64;
    const bf16_t* ap = A + (size_t)(MP + m0 + fr) * K + w * KS + fq * 8;
    const bf16_t* bp = Bt + (size_t)(n0 + fr) * K + w * KS + fq * 8;
    f32x4 acc[4];
#pragma unroll
    for (int mt = 0; mt < 4; ++mt) acc[mt] = (f32x4){0.f, 0.f, 0.f, 0.f};
#pragma unroll
    for (int s0 = 0; s0 < NST; s0 += NB) {
        bf16x8 bfr[NB], afr[NB][4];
#pragma unroll
        for (int i = 0; i < NB; ++i) if (s0 + i < NST) { bfr[i] = *(const bf16x8*)(bp + (s0 + i) * 32);
#pragma unroll
            for (int mt = 0; mt < 4; ++mt) afr[i][mt] = *(const bf16x8*)(ap + (size_t)(16 * mt) * K + (s0 + i) * 32); }
#pragma unroll
        for (int i = 0; i < NB; ++i) if (s0 + i < NST) {
#pragma unroll
            for (int mt = 0; mt < 4; ++mt) acc[mt] = mfma16(bfr[i], afr[i][mt], acc[mt]);
        }
    }
    LAS f32x4* xr = (LAS f32x4*)lds;
#pragma unroll
    for (int mt = 0; mt < 4; ++mt) xr[(w * 4 + mt) * 64 + lf] = acc[mt];
    LDS_SYNC();
    if (tid < 256) {
        const int mt = tid >> 6;
        f32x4 v = xr[mt * 64 + lf];
#pragma unroll
        for (int ww = 1; ww < 8; ++ww) v = v + xr[(ww * 4 + mt) * 64 + lf];
        const int m = m0 + 16 * mt + fr, c = n0 + 4 * fq;
        const f32x4 bv = *(const f32x4*)(base + (size_t)m * D + c), gv = *(const f32x4*)(mod + (size_t)(BP + m) * NMODC + gate_i * D + c);
        *(f32x4*)(outy + (size_t)(MP + m) * D + c) = bv + gv * v;
    }
    LDS_SYNC();
}

constexpr int RT_STRIDE = 272, RT_TILE = 128 * RT_STRIDE;
__device__ __forceinline__ bf16x8 rt_frag(const LAS unsigned char* tile, int row, int kel) { return *(const LAS bf16x8*)(tile + row * RT_STRIDE + kel * 2); }
__device__ __forceinline__ void phase4(LAS unsigned char* lds, int G, const bf16_t* Q, const bf16_t* Kb, const bf16_t* VT, const bf16_t* SPREV, const bf16_t* GATE, bf16_t* MIX,
                                       const bf16_t* WTout, const float* x_s, const float* mod, float* outy) {
    const int tid = threadIdx.x, lane = tid & 63, w = __builtin_amdgcn_readfirstlane(tid >> 6), wr = w >> 2, wc = w & 3, fr = lane & 15, fq = lane >> 4;
    LAS unsigned char* Tq = lds; LAS unsigned char* Tk = lds + RT_TILE; LAS unsigned char* Tv = lds + 2 * RT_TILE; LAS unsigned char* Ts = lds + 3 * RT_TILE;
    LAS float* red1 = (LAS float*)(lds + 4 * RT_TILE); LAS float* red2 = red1 + 512;
    for (int it = blockIdx.x; it < NBH * NCH + D / 8; it += G) {
        if (it >= NBH * NCH) { sample_proj_item<D>(lds, it - NBH * NCH, MIX, WTout, x_s, mod, 2, outy); continue; }
        const int bh = it / NCH, c = it % NCH, b = bh / NH, h = bh % NH;
        int lf = lane; asm volatile("" : "+v"(lf));
        const int fr = lf & 15, fq = lf >> 4;
        const float lg = lg2_gamma(h);
        const size_t row0 = (size_t)b * SEQ + c * 128;
#pragma unroll
        for (int i = 0; i < 4; ++i) {
            const int idx = tid + 512 * i, row = idx >> 4, ch = idx & 15;
            const u32x4 vq = *(const u32x4*)(Q + (row0 + row) * RW + h * HD + ch * 8);
            const u32x4 vk = *(const u32x4*)(Kb + (row0 + row) * RW + h * HD + ch * 8);
            const u32x4 vv = *(const u32x4*)(VT + ((size_t)bh * HD + row) * SEQ + c * 128 + ch * 8);
            const u32x4 vs = *(const u32x4*)(SPREV + (((size_t)bh * NCH + c) * HD + row) * HD + ch * 8);
            *(LAS u32x4*)(Tq + row * RT_STRIDE + ch * 16) = vq; *(LAS u32x4*)(Tk + row * RT_STRIDE + ch * 16) = vk;
            *(LAS u32x4*)(Tv + row * RT_STRIDE + ch * 16) = vv; *(LAS u32x4*)(Ts + row * RT_STRIDE + ch * 16) = vs;
        }
        BLOCK_SYNC();
        f32x4 sa[4][2], o[4][2];
#pragma unroll
        for (int mt = 0; mt < 4; ++mt)
#pragma unroll
            for (int nt = 0; nt < 2; ++nt) { sa[mt][nt] = (f32x4){0.f, 0.f, 0.f, 0.f}; o[mt][nt] = sa[mt][nt]; }
#pragma unroll 1
        for (int ks = 0; ks < 4; ++ks) {
            bf16x8 a[4], bk[2], bs[2];
#pragma unroll
            for (int mt = 0; mt < 4; ++mt) a[mt] = rt_frag(Tq, 64 * wr + 16 * mt + fr, ks * 32 + fq * 8);
#pragma unroll
            for (int nt = 0; nt < 2; ++nt) { bk[nt] = rt_frag(Tk, 32 * wc + 16 * nt + fr, ks * 32 + fq * 8); bs[nt] = rt_frag(Ts, 32 * wc + 16 * nt + fr, ks * 32 + fq * 8); }
#pragma unroll
            for (int mt = 0; mt < 4; ++mt)
#pragma unroll
                for (int nt = 0; nt < 2; ++nt) { sa[mt][nt] = mfma16(a[mt], bk[nt], sa[mt][nt]); o[mt][nt] = mfma16(a[mt], bs[nt], o[mt][nt]); }
        }
        LDS_SYNC();
#pragma unroll
        for (int mt = 0; mt < 4; ++mt)
#pragma unroll
            for (int j = 0; j < 4; ++j) {
                const int i = 64 * wr + 16 * mt + 4 * fq + j;
                const float qd = exp2f((float)(i + 1) * lg);
#pragma unroll
                for (int nt = 0; nt < 2; ++nt) {
                    const int jj = 32 * wc + 16 * nt + fr, dl = i - jj;
                    const float mv = dl >= 0 ? sa[mt][nt][j] * exp2f((float)dl * lg) : 0.f;
                    *(LAS bf16_t*)(Tk + i * RT_STRIDE + jj * 2) = (bf16_t)f2bf(mv);
                    o[mt][nt][j] *= qd;
                }
                asm volatile("" ::: "memory");
            }
        LDS_SYNC();
#pragma unroll 1
        for (int ks = 0; ks < 4; ++ks) {
            if (32 * ks > 64 * wr + 63) continue;
            bf16x8 a[4], bv[2];
#pragma unroll
            for (int mt = 0; mt < 4; ++mt) a[mt] = rt_frag(Tk, 64 * wr + 16 * mt + fr, ks * 32 + fq * 8);
#pragma unroll
            for (int nt = 0; nt < 2; ++nt) bv[nt] = rt_frag(Tv, 32 * wc + 16 * nt + fr, ks * 32 + fq * 8);
#pragma unroll
            for (int mt = 0; mt < 4; ++mt)
#pragma unroll
                for (int nt = 0; nt < 2; ++nt) o[mt][nt] = mfma16(a[mt], bv[nt], o[mt][nt]);
        }
#pragma unroll
        for (int mt = 0; mt < 4; ++mt)
#pragma unroll
            for (int j = 0; j < 4; ++j) {
                float s = o[mt][0][j] + o[mt][1][j];
                s += __shfl_xor(s, 1); s += __shfl_xor(s, 2); s += __shfl_xor(s, 4); s += __shfl_xor(s, 8);
                if (fr == 0) red1[(64 * wr + 16 * mt + 4 * fq + j) * 4 + wc] = s;
            }
        LDS_SYNC();
#pragma unroll
        for (int mt = 0; mt < 4; ++mt)
#pragma unroll
            for (int j = 0; j < 4; ++j) {
                const int i = 64 * wr + 16 * mt + 4 * fq + j;
                const f32x4 rs = *(const LAS f32x4*)(red1 + i * 4);
                const float mu = ((rs[0] + rs[1]) + (rs[2] + rs[3])) * (1.f / HD);
                o[mt][0][j] -= mu; o[mt][1][j] -= mu;
                float s = o[mt][0][j] * o[mt][0][j] + o[mt][1][j] * o[mt][1][j];
                s += __shfl_xor(s, 1); s += __shfl_xor(s, 2); s += __shfl_xor(s, 4); s += __shfl_xor(s, 8);
                if (fr == 0) red2[i * 4 + wc] = s;
            }
        LDS_SYNC();
#pragma unroll
        for (int mt = 0; mt < 4; ++mt)
#pragma unroll
            for (int j = 0; j < 4; ++j) {
                const int i = 64 * wr + 16 * mt + 4 * fq + j;
                const f32x4 rs = *(const LAS f32x4*)(red2 + i * 4);
                const float rstd = rsqrtf(((rs[0] + rs[1]) + (rs[2] + rs[3])) * (1.f / HD) + EPS);
#pragma unroll
                for (int nt = 0; nt < 2; ++nt) {
                    const int dv = 32 * wc + 16 * nt + fr;
                    const float gt = bf2f(GATE[(row0 + i) * RW + h * HD + dv]);
                    MIX[(row0 + i) * D + PW + h * HD + dv] = (bf16_t)f2bf(o[mt][nt][j] * rstd * gt);
                }
                asm volatile("" ::: "memory");
            }
        BLOCK_SYNC();
    }
}

__device__ __forceinline__ void phase_fix(LAS unsigned char* lds, int G, const float* AT, const float* AH, const float* BH, const float* cw, const float* cb, bf16_t* Gb,
                                          const bf16_t* WTfo, const float* mod, float* outy) {
    for (int it = G - 1 - (int)blockIdx.x; it < D / 8; it += G) sample_proj_item<DFF>(lds, it, Gb, WTfo, outy + (size_t)MP * D, mod, 5, outy);
    const int total = 64 * 2 * DFF;
    for (int idx = blockIdx.x * 512 + threadIdx.x; idx < total; idx += G * 512) {
        const int pm = idx / (2 * DFF), rem = idx % (2 * DFF), rr = rem / DFF, c = rem % DFF;
        if ((pm & 7) == 0) continue;
        const float a_m1 = rr == 0 ? AT[((size_t)(pm - 1) * 2 + 1) * DFF + c] : AH[((size_t)pm * 2 + 0) * DFF + c];
        const float a_m2 = rr == 0 ? AT[((size_t)(pm - 1) * 2 + 0) * DFF + c] : AT[((size_t)(pm - 1) * 2 + 1) * DFF + c];
        const float a0 = AH[((size_t)pm * 2 + rr) * DFF + c], bb = BH[((size_t)pm * 2 + rr) * DFF + c];
        const float cv = cw[c] * a_m2 + cw[DFF + c] * a_m1 + cw[2 * DFF + c] * a0 + cb[c];
        Gb[((size_t)pm * 256 + rr) * DFF + c] = (bf16_t)f2bf(silu_f(cv) * bb);
    }
}

#define XB_TMO      128
#define XB_XCNT(j)  (256  + 64 * (j))
#define XB_XSUB(j)  (1280 + 64 * (j))
#define XB_XGEN(j)  (2304 + 64 * (j))
#define XB_TOP      3328
#define XB_TOPGEN   3392
#define XCD_BAR_WORDS 3456
#define XB_SPIN_CAP (1u << 18)

__device__ __forceinline__ unsigned xb_ld(unsigned* p)              { return __hip_atomic_load(p, __ATOMIC_RELAXED, __HIP_MEMORY_SCOPE_AGENT); }
__device__ __forceinline__ unsigned xb_add(unsigned* p, unsigned v) { return __hip_atomic_fetch_add(p, v, __ATOMIC_RELAXED, __HIP_MEMORY_SCOPE_AGENT); }
__device__ __forceinline__ unsigned xb_xcc_id() { return (unsigned)__builtin_amdgcn_s_getreg((3 << 11) | 20) & 0xFu; }
#define XB_SPIN(cond, bar) do { unsigned _sp = 0; while (cond) { __builtin_amdgcn_s_sleep(1); \
    if ((++_sp & 255u) == 0u) { if (xb_ld(&(bar)[XB_TMO])) break; if (_sp > XB_SPIN_CAP) { atomicAdd(&(bar)[XB_TMO], 1u); break; } } } } while (0)

struct XcdBarrier {
    unsigned* bar; unsigned x;
    volatile LAS unsigned* st;
};

__device__ __forceinline__ XcdBarrier xcd_barrier_post(unsigned* bar, volatile LAS unsigned* st) {
    XcdBarrier b; b.bar = bar; b.x = xb_xcc_id(); b.st = st;
    if (threadIdx.x == 0) (void)xb_add(&bar[XB_XCNT(b.x)], 1u);
    return b;
}
__device__ __forceinline__ void xcd_barrier_complete(unsigned* bar, unsigned x, unsigned& nloc, unsigned& nx) {
    const unsigned G = gridDim.x * gridDim.y * gridDim.z;
    unsigned sum, cnt, mine, sp = 0u;
    for (;;) {
        sum = 0u; cnt = 0u; mine = 0u;
#pragma unroll
        for (unsigned j = 0; j < 16; ++j) { const unsigned c = xb_ld(&bar[XB_XCNT(j)]); sum += c; cnt += (c > 0u) ? 1u : 0u; mine = (j == x) ? c : mine; }
        if (sum == G) break;
        __builtin_amdgcn_s_sleep(1);
        if ((++sp & 255u) == 0u) { if (xb_ld(&bar[XB_TMO])) break; if (sp > XB_SPIN_CAP) { atomicAdd(&bar[XB_TMO], 1u); break; } }
    }
    nloc = mine > 0u ? mine : 1u; nx = cnt > 0u ? cnt : 1u;
}

__device__ __forceinline__ void xcd_barrier(const XcdBarrier& b) {
    asm volatile("s_waitcnt vmcnt(0)" ::: "memory");
    __syncthreads();
    if (threadIdx.x == 0) {
        unsigned* bar = b.bar;
        __builtin_amdgcn_s_waitcnt(0);
        unsigned nloc = b.st[0], nx = b.st[1];
        if (nloc == 0u) { xcd_barrier_complete(bar, b.x, nloc, nx); b.st[0] = nloc; b.st[1] = nx; }
        const unsigned old = xb_add(&bar[XB_XSUB(b.x)], 1u);
        const unsigned gen = old / nloc;
        if (old + 1u == (gen + 1u) * nloc) {
            __builtin_amdgcn_fence(__ATOMIC_RELEASE, "agent");
            asm volatile("s_waitcnt vmcnt(0)" ::: "memory");
            const unsigned og = xb_add(&bar[XB_TOP], 1u);
            const unsigned tg = og / nx;
            if (og + 1u == (tg + 1u) * nx) xb_add(&bar[XB_TOPGEN], 1u);
            else XB_SPIN(xb_ld(&bar[XB_TOPGEN]) == tg, bar);
            __builtin_amdgcn_fence(__ATOMIC_ACQUIRE, "agent");
            xb_add(&bar[XB_XGEN(b.x)], 1u);
            asm volatile("s_waitcnt vmcnt(0)" ::: "memory");
        } else {
            XB_SPIN(xb_ld(&bar[XB_XGEN(b.x)]) == gen, bar);
            __builtin_amdgcn_fence(__ATOMIC_ACQUIRE, "agent");
            asm volatile("s_waitcnt vmcnt(0)" ::: "memory");
        }
    }
    __syncthreads();
}


struct Args { const float* in[20]; float* out; unsigned char* ws; int ph_lo, ph_hi; };
__global__ void __launch_bounds__(512, 2) hymba_fwd(Args args) {
    extern __shared__ __attribute__((aligned(16))) unsigned char lds_raw[];
    LAS unsigned char* lds = (LAS unsigned char*)lds_raw;
    cg::grid_group grid = cg::this_grid();
    const int G = gridDim.x;
    unsigned char* ws = args.ws; float* out = args.out;
    const float *x_p = args.in[0], *x_s = args.in[1], *c_p = args.in[2], *c_s = args.in[3], *st_pool = args.in[4], *st_ret = args.in[5], *st_conv = args.in[6],
                *g_mix = args.in[7], *g_ffn = args.in[8], *w_ada = args.in[9], *b_ada = args.in[10], *w_in = args.in[11], *w_pool = args.in[12], *ls_pool = args.in[13],
                *w_out = args.in[14], *w_fi = args.in[15], *conv_w = args.in[16], *conv_b = args.in[17], *w_fo = args.in[18], *g_fin = args.in[19];
    float* mod = (float*)(ws + WS_MOD); float* rope = (float*)(ws + WS_ROPE); float* VS = (float*)(ws + WS_VS);
    bf16_t *WTin = (bf16_t*)(ws + WS_WIN), *WTout = (bf16_t*)(ws + WS_WOUT), *WTfi = (bf16_t*)(ws + WS_WFI), *WTfo = (bf16_t*)(ws + WS_WFO);
    float *AT = (float*)(ws + WS_HALO), *AH = AT + HALO_N, *BH = AH + HALO_N;
    bf16_t *RA = (bf16_t*)(ws + WS_RA), *RB = (bf16_t*)(ws + WS_RB), *Ub = (bf16_t*)(ws + WS_U), *GATE = (bf16_t*)(ws + WS_GATE), *Qb = (bf16_t*)(ws + WS_Q), *Kb = (bf16_t*)(ws + WS_K),
           *KT = (bf16_t*)(ws + WS_KT), *VT = (bf16_t*)(ws + WS_VT), *Gb = (bf16_t*)(ws + WS_G);
    bf16_t* SPREV = (bf16_t*)(out + O_YP);
    const int lo = args.ph_lo, hi = args.ph_hi;
#if MK_XCD_BARRIER && !MK_MULTI_LAUNCH
    volatile LAS unsigned* bst = (volatile LAS unsigned*)(lds + LDS_BYTES - 64);
    if (threadIdx.x < 4) bst[threadIdx.x] = 0u;
    __syncthreads();
    XcdBarrier xbar = xcd_barrier_post((unsigned*)(ws + WS_CTL), bst);
#endif
#ifndef PH_MASK
#define PH_MASK 0x7ff
#endif
#define IN(k) (((PH_MASK >> (k)) & 1) && lo <= (k) && (k) < hi)
#if MK_XCD_BARRIER && !MK_MULTI_LAUNCH
#define SEAM(k) do { if (IN(k) && IN((k) + 1)) { if (lo < 0) grid.sync(); else xcd_barrier(xbar); } } while (0)
#define SEAMX() xcd_barrier(xbar)
#else
#define SEAM(k) do { if (IN(k) && IN((k) + 1)) { grid.sync(); } } while (0)
#define SEAMX() grid.sync()
#endif

#ifndef PROBE_REP
#define PROBE_REP (-1)
#endif
#define PHASE(k, ...) do { if (IN(k)) { __VA_ARGS__; if (PROBE_REP == (k)) { SEAMX(); __VA_ARGS__; } } } while (0)
    PHASE(0, phase0(lds, G, c_p, c_s, w_ada, b_ada, w_in, w_out, w_fi, w_fo, mod, rope, WTin, WTout, WTfi, WTfo));
    SEAM(0);
    PHASE(1, norm_phase<0>(G, x_p, x_s, g_mix, mod, 0, 1, RA, nullptr));
    SEAM(1);
    PHASE(2, {
        pg8::Gemm g{RA, WTin, MPAD, INC, D}; pg8::StaticOrder S; S.init(MPAD, INC, G, (int)blockIdx.x);
        EpiIn E{Ub, Qb, Kb, KT, VT, GATE, VS, rope, out};
        pg8::gemm_phase<EpiIn, pg8::StaticOrder, true, true>(lds, g, S, E);
    });
    SEAM(2);
    #ifndef PROBE_SUB
#define PROBE_SUB 0
#endif
    if (IN(3)) { phase3(lds, G, Ub, Qb, Kb, KT, VT, GATE, VS, st_pool, st_ret, w_pool, ls_pool, SPREV, RB, out, 0);
        if (PROBE_SUB) { SEAMX(); phase3(lds, G, Ub, Qb, Kb, KT, VT, GATE, VS, st_pool, st_ret, w_pool, ls_pool, SPREV, RB, out, PROBE_SUB); } }
    SEAM(3);
    PHASE(4, phase4(lds, G, Qb, Kb, VT, SPREV, GATE, RB, WTout, x_s, mod, out + O_YP));
    SEAM(4);
    PHASE(5, {
        pg8::Gemm g{RB, WTout, MP, D, D}; pg8::StaticOrder S; S.init(MP, D, G, (int)blockIdx.x);
        EpiRes E{x_p, x_s, mod, 2, out + O_YP, 0};
        pg8::gemm_phase<EpiRes, pg8::StaticOrder, true, true>(lds, g, S, E);
    });
    SEAM(5);
    PHASE(6, norm_phase<1>(G, nullptr, nullptr, g_ffn, mod, 3, 4, RA, out + O_YP));
    SEAM(6);
    PHASE(7, {
        pg8::Gemm g{RA, WTfi, MPAD, NFF, D}; pg8::StaticOrder S; S.init(MPAD, NFF, G, (int)blockIdx.x);
        EpiFfn E{Gb, AT, AH, BH, conv_w, conv_b, st_conv, out, (LAS float*)(lds + LDS_X)};
        pg8::gemm_phase<EpiFfn, pg8::StaticOrder, true, true>(lds, g, S, E);
    });
    SEAM(7);
    PHASE(8, phase_fix(lds, G, AT, AH, BH, conv_w, conv_b, Gb, WTfo, mod, out + O_YP));
    SEAM(8);
    PHASE(9, {
        pg8::Gemm g{Gb, WTfo, MP, D, DFF}; pg8::StaticOrder S; S.init(MP, D, G, (int)blockIdx.x);
        EpiRes E{nullptr, nullptr, mod, 5, out + O_YP, 1};
        pg8::gemm_phase<EpiRes, pg8::StaticOrder, true, true>(lds, g, S, E);
    });
    SEAM(9);
    PHASE(10, norm_phase<2>(G, nullptr, nullptr, g_fin, nullptr, 0, 0, nullptr, out + O_YP));
#undef PHASE
#undef IN
#undef SEAM
#undef SEAMX
}

extern "C" void kernel_launch(void* const* d_in, const int* in_sizes, int n_in, void* d_out, int out_size, void* d_ws, size_t ws_size, hipStream_t stream) {
    static int grid = 0;
    if (grid == 0) {
        if (n_in != 20 || (size_t)out_size != O_END || ws_size < WS_END) { fprintf(stderr, "kernel_launch: unexpected problem shape (n_in %d, out %d, ws %zu)\n", n_in, out_size, ws_size); grid = -1; return; }
        int dev = 0, cus = 0, per_cu = 0;
        (void)hipGetDevice(&dev); (void)hipDeviceGetAttribute(&cus, hipDeviceAttributeMultiprocessorCount, dev);
        if (hipFuncSetAttribute((const void*)hymba_fwd, hipFuncAttributeMaxDynamicSharedMemorySize, LDS_BYTES) != hipSuccess) { fprintf(stderr, "kernel_launch: hipFuncSetAttribute failed\n"); grid = -1; return; }
        if (hipOccupancyMaxActiveBlocksPerMultiprocessor(&per_cu, (const void*)hymba_fwd, 512, LDS_BYTES) != hipSuccess || per_cu < 1) per_cu = 1;
        (void)hipGetLastError();
        grid = cus * per_cu;
        if (grid <= 0) grid = 256;
    }
    if (grid < 0) return;
    Args a{};
    for (int i = 0; i < 20; ++i) a.in[i] = (const float*)d_in[i];
    a.out = (float*)d_out; a.ws = (unsigned char*)d_ws;
#if MK_MULTI_LAUNCH
    for (int ph = 0; ph < NPHASE; ++ph) { a.ph_lo = ph; a.ph_hi = ph + 1; hipLaunchKernelGGL(hymba_fwd, dim3(grid), dim3(512), LDS_BYTES, stream, a); }
#else
    a.ph_lo = 0; a.ph_hi = NPHASE;
#if MK_XCD_BARRIER
    (void)hipMemsetAsync((char*)d_ws + WS_CTL, 0, 16384, stream);
#endif
    void* kargs[] = {&a};
    hipError_t e = hipLaunchCooperativeKernel((const void*)hymba_fwd, dim3(grid), dim3(512), kargs, LDS_BYTES, stream);
    if (e != hipSuccess) fprintf(stderr, "kernel_launch: cooperative launch failed: %s (grid %d)\n", hipGetErrorString(e), grid);
#endif
}
```

```cpp
#include <hip/hip_runtime.h>
#include <hip/hip_cooperative_groups.h>
#include <cstdio>
#include <cstdint>
namespace cg = cooperative_groups;

#ifndef MK_MULTI_LAUNCH
#define MK_MULTI_LAUNCH 0
#endif
#ifndef MK_XCD_BARRIER
#define MK_XCD_BARRIER 1
#endif

namespace pg8 {
#define PG8_LAS __attribute__((address_space(3)))
typedef unsigned short bf16_t;
typedef short bf16x8 __attribute__((ext_vector_type(8)));
typedef float f32x4 __attribute__((ext_vector_type(4)));
typedef unsigned u32x4 __attribute__((ext_vector_type(4)));
constexpr int BM = 256, BK = 64, HALF = 128, HTB = HALF * BK * 2  , STAGE_BYTES = 8 * HTB, NXCD = 8, WGM = 8;

__host__ __device__ __forceinline__ int lds_byte(int r, int c) { const int st = (r >> 4) * 2 + (c >> 5), rr = r & 15, cc = c & 31, ob = rr * 64 + cc * 2; return st * 1024 + (ob ^ (((ob >> 9) & 1) << 5)); }
__host__ __device__ __forceinline__ void stage_rc(int b, int& R, int& C) { const int st = b / 1024, sb = b % 1024, swz = sb ^ (((sb >> 9) & 1) << 5); R = (st >> 1) * 16 + swz / 64; C = (st & 1) * 32 + (swz % 64) / 2; }
__host__ __device__ __forceinline__ int perm32(int rho) { const int n = rho >> 4, i = rho & 15; return 8 * (i >> 2) + 4 * n + (i & 3); }

struct Unit { int pm, pn; };
struct Gemm { const bf16_t* A; const bf16_t* Bt; int M, N, K; };

struct StaticOrder {
    int nM, nN, nwg, G, c;
    __host__ __device__ void init(int M, int N, int G_, int c_) { nM = M / BM; nN = N / BM; nwg = nM * nN; G = G_; c = c_; }
    __host__ __device__ bool next(int i, Unit& u) const {
        const long L = (long)i * G + c; if (L >= nwg) return false;
        int wgid = (int)L; { const int q = nwg / NXCD, r = nwg % NXCD, xcd = wgid % NXCD, off = wgid / NXCD; wgid = (xcd < r ? xcd * (q + 1) : r * (q + 1) + (xcd - r) * q) + off; }
        const int nig = WGM * nN, gid = wgid / nig, fm = gid * WGM, gsz = (nM - fm) < WGM ? (nM - fm) : WGM;
        u.pm = fm + ((wgid % nig) % gsz); u.pn = (wgid % nig) / gsz; return true;
    }
    __device__ __forceinline__ void a_ready(const Unit&) const {}
    __device__ __forceinline__ void done(const Unit&) const {}
};

__device__ __forceinline__ unsigned cvt_pk_bf16(float lo, float hi) { unsigned r; asm volatile("v_cvt_pk_bf16_f32 %0, %1, %2" : "=v"(r) : "v"(lo), "v"(hi)); return r; }
template <class Epi, class Sched, bool ALIGN_EPI = false, bool SP2 = false>
__device__ __forceinline__ void gemm_phase(PG8_LAS unsigned char* lds, const Gemm g, const Sched& S, const Epi& E) {
    const int tid = threadIdx.x, wid = __builtin_amdgcn_readfirstlane(tid >> 6), lane = tid & 63, wr = wid >> 2, wc = wid & 3, fr = lane & 15, fq = lane >> 4;
    const int K = g.K, nt = K / BK;
    unsigned voffA[2], voffB[2];
#pragma unroll
    for (int i = 0; i < 2; ++i) { int R, C; stage_rc(tid * 16 + i * 8192, R, C); const int Rb = Epi::PERM ? ((R & ~31) + perm32(R & 31)) : R;
        voffA[i] = (unsigned)(R * K + C) * 2u; voffB[i] = (unsigned)(Rb * K + C) * 2u; }
    const size_t kstep = (size_t)(BK * 2);
    const size_t hstep = (size_t)HALF * K * 2;
    const size_t tstep = 2 * hstep;
    const unsigned ldsw = (unsigned)wid * 1024u;
    const int aoff = lds_byte(wr * 64 + fr, fq * 8), boff = lds_byte(wc * 32 + fr, fq * 8);
#define PG8_SA(b, h) (((b) * 2 + (h)) * HTB)
#define PG8_SB(b, h) ((4 + (b) * 2 + (h)) * HTB)
#define PG8_STAGE(bufoff, gbase, voff) do { _Pragma("unroll") for (int _i = 0; _i < 2; ++_i) \
        __builtin_amdgcn_global_load_lds((const unsigned*)((const char*)(gbase) + (voff)[_i]), (PG8_LAS unsigned*)(lds + (bufoff) + ldsw + _i * 8192), 16, 0, 0); } while (0)
#define PG8_LDA(dst, b, h) do { _Pragma("unroll") for (int m = 0; m < 4; ++m) _Pragma("unroll") for (int k = 0; k < 2; ++k) dst[m][k] = *(const PG8_LAS bf16x8*)(lds + PG8_SA(b, h) + aoff + m * 2048 + k * 1024); } while (0)
#define PG8_LDB(dst, b, h) do { _Pragma("unroll") for (int n = 0; n < 2; ++n) _Pragma("unroll") for (int k = 0; k < 2; ++k) dst[n][k] = *(const PG8_LAS bf16x8*)(lds + PG8_SB(b, h) + boff + n * 2048 + k * 1024); } while (0)
#define PG8_MMA(ai, bj, At, Bt) do { __builtin_amdgcn_s_setprio(1); _Pragma("unroll") for (int m = 0; m < 4; ++m) _Pragma("unroll") for (int n = 0; n < 2; ++n) _Pragma("unroll") for (int k = 0; k < 2; ++k) \
        acc[ai][bj][m][n] = __builtin_amdgcn_mfma_f32_16x16x32_bf16(Bt[n][k], At[m][k], acc[ai][bj][m][n], 0, 0, 0); __builtin_amdgcn_s_setprio(0); } while (0)
#define PG8_WAIT_V(n) asm volatile("s_waitcnt vmcnt(" #n ")" ::: "memory")
#define PG8_WAIT_L(n) asm volatile("s_waitcnt lgkmcnt(" #n ")" ::: "memory")
#define PG8_BAR __builtin_amdgcn_s_barrier()
#define PG8_SCHED __builtin_amdgcn_sched_barrier(0)
    Unit cur, nxt; int ui = 0;
    if (!S.next(0, cur)) return;
    f32x4 acc[2][2][4][2];
#pragma unroll
    for (int a = 0; a < 2; ++a)
#pragma unroll
        for (int b = 0; b < 2; ++b)
#pragma unroll
            for (int m = 0; m < 4; ++m)
#pragma unroll
                for (int n = 0; n < 2; ++n) acc[a][b][m][n] = (f32x4){0.f, 0.f, 0.f, 0.f};
    bf16x8 At[4][2], B0[2][2], B1[2][2];
    const char* cA = (const char*)g.A + (size_t)cur.pm * tstep; const char* cB = (const char*)g.Bt + (size_t)cur.pn * tstep;
    S.a_ready(cur);
    if constexpr (SP2) {
        PG8_STAGE(PG8_SB(0, 0), cB, voffB); PG8_STAGE(PG8_SB(0, 1), cB + hstep, voffB); PG8_STAGE(PG8_SA(0, 0), cA, voffA); PG8_STAGE(PG8_SA(0, 1), cA + hstep, voffA);
        if (wr == 1) PG8_BAR;
        PG8_WAIT_V(2); PG8_BAR;
        PG8_STAGE(PG8_SB(1, 0), cB + kstep, voffB); PG8_STAGE(PG8_SA(1, 0), cA + kstep, voffA); PG8_STAGE(PG8_SB(1, 1), cB + hstep + kstep, voffB);
        PG8_WAIT_V(6); PG8_BAR;
    } else {
        PG8_STAGE(PG8_SB(0, 0), cB, voffB); PG8_STAGE(PG8_SA(0, 0), cA, voffA); PG8_STAGE(PG8_SB(0, 1), cB + hstep, voffB); PG8_STAGE(PG8_SA(0, 1), cA + hstep, voffA);
        if (wr == 1) PG8_BAR;
        PG8_WAIT_V(4); PG8_BAR;
        PG8_STAGE(PG8_SB(1, 0), cB + kstep, voffB); PG8_STAGE(PG8_SA(1, 0), cA + kstep, voffA); PG8_STAGE(PG8_SB(1, 1), cB + hstep + kstep, voffB);
        PG8_WAIT_V(6); PG8_BAR;
    }
    for (;;) {
        const bool has_next = S.next(ui + 1, nxt);
        const char* nA = has_next ? (const char*)g.A + (size_t)nxt.pm * tstep : cA; const char* nB = has_next ? (const char*)g.Bt + (size_t)nxt.pn * tstep : cB;
        for (int t = 0; t < nt; t += 2) {
            const bool last = (t == nt - 2);
            const char* a1 = cA + (size_t)(t + 1) * kstep;
            const char* a2 = last ? nA : cA + (size_t)(t + 2) * kstep; const char* b2 = last ? nB : cB + (size_t)(t + 2) * kstep;
            const char* a3 = a2 + kstep; const char* b3 = b2 + kstep;
            if (last && has_next) S.a_ready(nxt);
            if constexpr (SP2) {
            PG8_LDB(B0, 0, 0); PG8_LDB(B1, 0, 1); PG8_SCHED; PG8_LDA(At, 0, 0); PG8_STAGE(PG8_SA(1, 1), a1 + hstep, voffA);
            PG8_WAIT_V(8); PG8_WAIT_L(0); PG8_BAR; PG8_MMA(0, 0, At, B0); PG8_MMA(0, 1, At, B1); PG8_BAR; PG8_SCHED;
            PG8_LDA(At, 0, 1); PG8_STAGE(PG8_SB(0, 0), b2, voffB); PG8_STAGE(PG8_SB(0, 1), b2 + hstep, voffB); PG8_STAGE(PG8_SA(0, 0), a2, voffA);
            PG8_WAIT_V(8); PG8_WAIT_L(0); PG8_BAR; PG8_MMA(1, 0, At, B0); PG8_MMA(1, 1, At, B1); PG8_BAR; PG8_SCHED;
            PG8_LDB(B0, 1, 0); PG8_LDB(B1, 1, 1); PG8_SCHED; PG8_LDA(At, 1, 0); PG8_STAGE(PG8_SA(0, 1), a2 + hstep, voffA);
            PG8_WAIT_V(8); PG8_WAIT_L(0); PG8_BAR; PG8_MMA(0, 0, At, B0); PG8_MMA(0, 1, At, B1); PG8_BAR; PG8_SCHED;
            PG8_LDA(At, 1, 1); PG8_STAGE(PG8_SB(1, 0), b3, voffB); PG8_STAGE(PG8_SB(1, 1), b3 + hstep, voffB); PG8_STAGE(PG8_SA(1, 0), a3, voffA);
            PG8_WAIT_V(8); PG8_WAIT_L(0); PG8_BAR; PG8_MMA(1, 0, At, B0); PG8_MMA(1, 1, At, B1); PG8_BAR; PG8_SCHED;
            } else {
            PG8_LDB(B0, 0, 0); PG8_SCHED; PG8_LDA(At, 0, 0); PG8_STAGE(PG8_SA(1, 1), a1 + hstep, voffA);
            PG8_WAIT_L(8); PG8_BAR; PG8_WAIT_L(0); PG8_MMA(0, 0, At, B0); PG8_BAR; PG8_SCHED;
            PG8_LDB(B1, 0, 1); PG8_STAGE(PG8_SB(0, 0), b2, voffB);
            PG8_BAR; PG8_WAIT_L(0); PG8_MMA(0, 1, At, B1); PG8_BAR;
            PG8_LDA(At, 0, 1); PG8_STAGE(PG8_SA(0, 0), a2, voffA);
            PG8_BAR; PG8_WAIT_L(0); PG8_MMA(1, 0, At, B0); PG8_BAR; PG8_SCHED;
            PG8_STAGE(PG8_SB(0, 1), b2 + hstep, voffB);
            PG8_WAIT_V(6); PG8_BAR; PG8_MMA(1, 1, At, B1); PG8_BAR;
            PG8_LDB(B0, 1, 0); PG8_SCHED; PG8_LDA(At, 1, 0); PG8_STAGE(PG8_SA(0, 1), a2 + hstep, voffA);
            PG8_WAIT_L(8); PG8_BAR; PG8_WAIT_L(0); PG8_MMA(0, 0, At, B0); PG8_BAR; PG8_SCHED;
            PG8_LDB(B1, 1, 1); PG8_STAGE(PG8_SB(1, 0), b3, voffB);
            PG8_BAR; PG8_WAIT_L(0); PG8_MMA(0, 1, At, B1); PG8_BAR;
            PG8_LDA(At, 1, 1); PG8_STAGE(PG8_SA(1, 0), a3, voffA);
            PG8_BAR; PG8_WAIT_L(0); PG8_MMA(1, 0, At, B0); PG8_BAR; PG8_SCHED;
            PG8_STAGE(PG8_SB(1, 1), b3 + hstep, voffB);
            PG8_WAIT_V(6); PG8_BAR; PG8_MMA(1, 1, At, B1); PG8_BAR;
            }
        }
        if constexpr (ALIGN_EPI) { if (wr == 0) PG8_BAR; }
        if constexpr (!Epi::AFTER_DRAIN) { E(acc, cur, wr, wc, fr, fq); S.done(cur); }
        if (!has_next) break;
#pragma unroll
        for (int a = 0; a < 2; ++a)
#pragma unroll
            for (int b = 0; b < 2; ++b)
#pragma unroll
                for (int m = 0; m < 4; ++m)
#pragma unroll
                    for (int n = 0; n < 2; ++n) acc[a][b][m][n] = (f32x4){0.f, 0.f, 0.f, 0.f};
        cur = nxt; cA = nA; cB = nB; ++ui;
        if constexpr (ALIGN_EPI) { if (wr == 1) PG8_BAR; }
    }
    PG8_WAIT_V(0);
    if constexpr (!ALIGN_EPI) { if (wr == 0) PG8_BAR; }
    PG8_BAR;
    if constexpr (Epi::AFTER_DRAIN) { E.fused(acc, cur, wr, wc, fr, fq, lds, wid, lane); S.done(cur); }
#undef PG8_SA
#undef PG8_SB
#undef PG8_STAGE
#undef PG8_LDA
#undef PG8_LDB
#undef PG8_MMA
#undef PG8_WAIT_V
#undef PG8_WAIT_L
#undef PG8_BAR
#undef PG8_SCHED
}
}

#define LAS __attribute__((address_space(3)))
typedef unsigned short bf16_t;
typedef float f32x4 __attribute__((ext_vector_type(4)));
typedef short bf16x8 __attribute__((ext_vector_type(8)));
typedef unsigned u32x4 __attribute__((ext_vector_type(4)));
typedef unsigned u32x2 __attribute__((ext_vector_type(2)));

constexpr int D = 1024, BP = 8, SEQ = 2048, MP = BP * SEQ, BS = 128, MR = MP + BS, MPAD = 16640;
constexpr int PW = 256, RW = 768, NH = 6, HD = 128, INC = 3328, DFF = 2816, NFF = 5632, NMODC = 6 * D;
constexpr int NCH = SEQ / 128, NBH = BP * NH;
constexpr float EPS = 1e-6f;
constexpr size_t O_YP = 0, O_YS = 16777216, O_PP = 16908288, O_RP = 16939008, O_CP = 17725440, O_PS = 17770496, O_RS = 18262016, O_CS = 30844928, O_END = 31565824;
constexpr size_t MiB = 1u << 20;
constexpr size_t WS_CTL = 0, WS_MOD = 1 * MiB, WS_ROPE = 5 * MiB, WS_VS = 7 * MiB, WS_WIN = 8 * MiB, WS_WOUT = 15 * MiB, WS_WFI = 17 * MiB, WS_WFO = 28 * MiB,
                 WS_HALO = 34 * MiB, WS_RA = 40 * MiB, WS_RB = 73 * MiB, WS_U = 106 * MiB, WS_GATE = 115 * MiB, WS_Q = 140 * MiB, WS_K = 165 * MiB,
                 WS_KT = 190 * MiB, WS_VT = 214 * MiB, WS_G = 140 * MiB, WS_END = 238 * MiB;
constexpr size_t HALO_N = (size_t)65 * 2 * DFF;
constexpr int LDS_BYTES = 147456;
constexpr int LDS_X = 131072;
constexpr int NPHASE = 11;

__device__ __forceinline__ float bf2f(unsigned v) { return __uint_as_float(v << 16); }
__device__ __forceinline__ unsigned f2bf(float f) { unsigned u = __float_as_uint(f); return (u + 0x7fffu + ((u >> 16) & 1u)) >> 16; }
__device__ __forceinline__ unsigned pk2(float lo, float hi) { return pg8::cvt_pk_bf16(lo, hi); }
__device__ __forceinline__ float silu_f(float x) { return x / (1.f + __expf(-x)); }
__device__ __forceinline__ float wave_sum(float v) {
#pragma unroll
    for (int o = 1; o < 64; o <<= 1) v += __shfl_xor(v, o);
    return v;
}
__device__ __forceinline__ float lg2_gamma(int h) { return log2f(1.0f - exp2f(-5.0f - (float)h)); }
__device__ __forceinline__ f32x4 mfma16(bf16x8 a, bf16x8 b, f32x4 c) { return __builtin_amdgcn_mfma_f32_16x16x32_bf16(a, b, c, 0, 0, 0); }
#define BLOCK_SYNC() do { asm volatile("s_waitcnt vmcnt(0) lgkmcnt(0)" ::: "memory"); __builtin_amdgcn_s_barrier(); asm volatile("" ::: "memory"); } while (0)
#define LDS_SYNC() do { asm volatile("s_waitcnt lgkmcnt(0)" ::: "memory"); __builtin_amdgcn_s_barrier(); asm volatile("" ::: "memory"); } while (0)

template <int MAP> __device__ __forceinline__ int wrow_map(int c) {
    if (MAP == 1) return (c & ~127) | (32 * ((c & 63) >> 4) + 16 * ((c & 127) >> 6) + (c & 15));
    if (MAP == 2) { const int a = c < DFF ? c : c - DFF; return 256 * (a >> 7) + (c < DFF ? 0 : 128) + (a & 127); }
    return c;
}
template <int MAP> __device__ __forceinline__ void p0_transpose_item(const float* __restrict__ W, int K, int N, bf16_t* __restrict__ WT, LAS float* scr, int item, int lane) {
    const int nblk = N / 32, kb = item / nblk, nb = item % nblk, k0 = 64 * kb, n0 = 32 * nb;
    float tv[32];
#pragma unroll
    for (int i = 0; i < 32; ++i) { const int kk = 2 * i + (lane >> 5); tv[i] = W[(size_t)(k0 + kk) * N + n0 + (lane & 31)]; }
#pragma unroll
    for (int i = 0; i < 32; ++i) { const int kk = 2 * i + (lane >> 5); scr[kk * 33 + (lane & 31)] = tv[i]; }
    asm volatile("s_waitcnt lgkmcnt(0)" ::: "memory");
    const int c = lane & 7;
#pragma unroll
    for (int j = 0; j < 4; ++j) { const int n = (lane >> 3) + 8 * j; const LAS float* s = scr + (8 * c) * 33 + n;
        u32x4 o; o.x = pk2(s[0 * 33], s[1 * 33]); o.y = pk2(s[2 * 33], s[3 * 33]); o.z = pk2(s[4 * 33], s[5 * 33]); o.w = pk2(s[6 * 33], s[7 * 33]);
        *(u32x4*)(WT + (size_t)wrow_map<MAP>(n0 + n) * K + k0 + 8 * c) = o; }
    asm volatile("s_waitcnt lgkmcnt(0)" ::: "memory");
}

__device__ __forceinline__ void phase0(LAS unsigned char* lds, int G, const float* c_p, const float* c_s, const float* w_ada, const float* b_ada,
                                       const float* w_in, const float* w_out, const float* w_fi, const float* w_fo,
                                       float* mod, float* rope, bf16_t* WTin, bf16_t* WTout, bf16_t* WTfi, bf16_t* WTfo) {
    const int tid = threadIdx.x, lane = tid & 63, w = __builtin_amdgcn_readfirstlane(tid >> 6), fr = lane & 15, fq = lane >> 4;
    LAS float* red = (LAS float*)lds;
    for (int it = blockIdx.x; it < NMODC / 32; it += G) {
        const int n0 = it * 32;
        f32x4 acc[9][2];
#pragma unroll
        for (int mt = 0; mt < 9; ++mt) { acc[mt][0] = (f32x4){0.f, 0.f, 0.f, 0.f}; acc[mt][1] = (f32x4){0.f, 0.f, 0.f, 0.f}; }
#pragma unroll 2
        for (int ks = 0; ks < 4; ++ks) {
            const int k0 = 128 * w + 32 * ks + fq * 8;
            bf16x8 bfr[2];
#pragma unroll
            for (int nt = 0; nt < 2; ++nt) {
                const float* wp = w_ada + (size_t)k0 * NMODC + n0 + 16 * nt + fr;
                float t[8];
#pragma unroll
                for (int j = 0; j < 8; ++j) t[j] = wp[(size_t)j * NMODC];
                u32x4 pk; pk.x = pk2(t[0], t[1]); pk.y = pk2(t[2], t[3]); pk.z = pk2(t[4], t[5]); pk.w = pk2(t[6], t[7]);
                bfr[nt] = __builtin_bit_cast(bf16x8, pk);
            }
#pragma unroll
            for (int mt = 0; mt < 9; ++mt) {
                const int row = 16 * mt + fr;
                u32x4 pk = (u32x4){0u, 0u, 0u, 0u};
                if (row < BP + BS) {
                    const float* cp = (row < BP ? c_p + (size_t)row * D : c_s + (size_t)(row - BP) * D) + k0;
                    const f32x4 a0 = *(const f32x4*)cp, a1 = *(const f32x4*)(cp + 4);
                    pk.x = pk2(silu_f(a0[0]), silu_f(a0[1])); pk.y = pk2(silu_f(a0[2]), silu_f(a0[3]));
                    pk.z = pk2(silu_f(a1[0]), silu_f(a1[1])); pk.w = pk2(silu_f(a1[2]), silu_f(a1[3]));
                }
                const bf16x8 afr = __builtin_bit_cast(bf16x8, pk);
                acc[mt][0] = mfma16(afr, bfr[0], acc[mt][0]);
                acc[mt][1] = mfma16(afr, bfr[1], acc[mt][1]);
            }
        }
#pragma unroll 1
        for (int r = 0; r < 8; ++r) {
            if (w == r) {
#pragma unroll
                for (int mt = 0; mt < 9; ++mt)
#pragma unroll
                    for (int nt = 0; nt < 2; ++nt)
#pragma unroll
                        for (int j = 0; j < 4; ++j) { const int idx = (16 * mt + 4 * fq + j) * 32 + 16 * nt + fr; red[idx] = (r == 0 ? 0.f : red[idx]) + acc[mt][nt][j]; }
            }
            LDS_SYNC();
        }
        for (int idx = tid; idx < (BP + BS) * 32; idx += 512) { const int row = idx >> 5, c = idx & 31; mod[(size_t)row * NMODC + n0 + c] = red[idx] + b_ada[n0 + c]; }
        LDS_SYNC();
    }
    {
        LAS float* scr = (LAS float*)(lds + w * 16384);
        const int gw = blockIdx.x * 8 + w, NGW = G * 8;
        constexpr int I_IN = (D / 64) * (INC / 32), I_OUT = (D / 64) * (D / 32), I_FI = (D / 64) * (NFF / 32), I_FO = (DFF / 64) * (D / 32);
        constexpr int NITEMS = I_IN + I_OUT + I_FI + I_FO;
        for (int it = NITEMS - 1 - gw; it >= 0; it -= NGW) {
            int r = it;
            if (r < I_IN) { p0_transpose_item<1>(w_in, D, INC, WTin, scr, r, lane); continue; } r -= I_IN;
            if (r < I_OUT) { p0_transpose_item<0>(w_out, D, D, WTout, scr, r, lane); continue; } r -= I_OUT;
            if (r < I_FI) { p0_transpose_item<2>(w_fi, D, NFF, WTfi, scr, r, lane); continue; } r -= I_FI;
            p0_transpose_item<0>(w_fo, DFF, D, WTfo, scr, r, lane);
        }
    }
    for (int idx = blockIdx.x * 512 + tid; idx < (SEQ + 1) * 64; idx += G * 512) {
        const int ps = idx >> 6, i = idx & 63;
        const double pos = ps == SEQ ? 16384.0 : (double)ps;
        const double inv = exp(-(double)i * (9.210340371976184 / 64.0));
        double s, c; sincos(pos * inv, &s, &c);
        rope[(size_t)ps * 128 + i] = (float)c; rope[(size_t)ps * 128 + 64 + i] = (float)s;
    }
}

template <int MODE> __device__ __forceinline__ void norm_phase(int G, const float* xp, const float* xs, const float* gvec, const float* mod, int sh_i, int sc_i, bf16_t* H, float* outy) {
    const int tid = threadIdx.x, lane = tid & 63, w = tid >> 6;
    const int gw = blockIdx.x * 8 + w, NGW = G * 8;
    const int nrows = MODE == 2 ? MR : MPAD;
    for (int r = gw; r < nrows; r += NGW) {
        if (MODE != 2 && r >= MR) {
            u32x2* o = (u32x2*)(H + (size_t)r * D) + lane;
#pragma unroll
            for (int j = 0; j < 4; ++j) o[64 * j] = (u32x2){0u, 0u};
            continue;
        }
        const float* src = MODE == 0 ? (r < MP ? xp + (size_t)r * D : xs + (size_t)(r - MP) * D) : outy + (size_t)r * D;
        const f32x4* xr = (const f32x4*)src + lane;
        f32x4 v[4]; float ss = 0.f;
#pragma unroll
        for (int j = 0; j < 4; ++j) { v[j] = xr[64 * j]; ss += (v[j][0] * v[j][0] + v[j][1] * v[j][1]) + (v[j][2] * v[j][2] + v[j][3] * v[j][3]); }
        const float rstd = rsqrtf(wave_sum(ss) * (1.f / D) + EPS);
        if (MODE == 2) {
            f32x4* o = (f32x4*)(outy + (size_t)r * D) + lane;
#pragma unroll
            for (int j = 0; j < 4; ++j) { const f32x4 g4 = ((const f32x4*)gvec)[lane + 64 * j]; o[64 * j] = v[j] * rstd * g4; }
        } else {
            const int nb = r < MP ? (r >> 11) : BP + (r - MP);
            const f32x4* scp = (const f32x4*)(mod + (size_t)nb * NMODC + sc_i * D) + lane;
            const f32x4* shp = (const f32x4*)(mod + (size_t)nb * NMODC + sh_i * D) + lane;
            u32x2* o = (u32x2*)(H + (size_t)r * D) + lane;
#pragma unroll
            for (int j = 0; j < 4; ++j) { const f32x4 g4 = ((const f32x4*)gvec)[lane + 64 * j], sc = scp[64 * j], sh = shp[64 * j];
                const f32x4 y = v[j] * rstd * g4 * (sc + 1.0f) + sh;
                o[64 * j] = (u32x2){pk2(y[0], y[1]), pk2(y[2], y[3])}; }
        }
    }
}

struct EpiIn {
    static constexpr bool PERM = false, AFTER_DRAIN = false;
    bf16_t *U, *Q, *Kb, *KT, *VT, *GATE; float* VS; const float* rope; float* out;
    __device__ __forceinline__ void operator()(const f32x4 (&acc)[2][2][4][2], const pg8::Unit& u, int wr, int wc, int fr, int fq) const {
        asm volatile("" : "+v"(fr), "+v"(fq));
        const int p0 = 16 * wc + 4 * fq;
#pragma unroll
        for (int bj = 0; bj < 2; ++bj) {
            const int blk = 2 * u.pn + bj;
            const int region = blk < 2 ? 0 : 1 + (blk - 2) / NH, h = blk < 2 ? blk : (blk - 2) % NH;
            const float lg = lg2_gamma(h);
#pragma unroll
            for (int ai = 0; ai < 2; ++ai) {
                f32x4 rc[4], rs[4];
                if (region == 1 || region == 2) {
#pragma unroll
                    for (int m = 0; m < 4; ++m) {
                        const int r = u.pm * 256 + ai * 128 + wr * 64 + m * 16 + fr;
                        const float* cs = rope + (size_t)(r >= MP ? SEQ : (r & (SEQ - 1))) * 128 + p0;
                        rc[m] = *(const f32x4*)cs; rs[m] = *(const f32x4*)(cs + 64);
                    }
                }
#pragma unroll
                for (int m = 0; m < 4; ++m) {
                    const int r = u.pm * 256 + ai * 128 + wr * 64 + m * 16 + fr;
                    if (r >= MR) continue;
                    const bool samp = r >= MP; const int b = r >> 11, t = r & (SEQ - 1), bs = r - MP;
                    const f32x4 v0 = acc[ai][bj][m][0], v1 = acc[ai][bj][m][1];
                    if (region == 0) {
                        const int c0 = 128 * h + p0;
                        *(u32x2*)(U + (size_t)r * PW + c0) = (u32x2){pk2(v0[0], v0[1]), pk2(v0[2], v0[3])};
                        *(u32x2*)(U + (size_t)r * PW + c0 + 64) = (u32x2){pk2(v1[0], v1[1]), pk2(v1[2], v1[3])};
                        if (samp) { float* o = out + O_PS + ((size_t)bs * 15 + 14) * PW + c0; *(f32x4*)o = v0; *(f32x4*)(o + 64) = v1; }
                        else if (t >= SEQ - 15) { float* o = out + O_PP + ((size_t)b * 15 + (t - (SEQ - 15))) * PW + c0; *(f32x4*)o = v0; *(f32x4*)(o + 64) = v1; }
                    } else if (region == 1 || region == 2) {
                        const f32x4 c4 = rc[m], s4 = rs[m];
                        f32x4 o1 = v0 * c4 - v1 * s4, o2 = v0 * s4 + v1 * c4;
                        if (region == 2) { o1 = o1 * 0.08838834764831845f; o2 = o2 * 0.08838834764831845f; }
                        bf16_t* dst = (region == 1 ? Q : Kb) + (size_t)r * RW + h * HD + p0;
                        *(u32x2*)dst = (u32x2){pk2(o1[0], o1[1]), pk2(o1[2], o1[3])};
                        *(u32x2*)(dst + 64) = (u32x2){pk2(o2[0], o2[1]), pk2(o2[2], o2[3])};
                        if (region == 2 && !samp) {
                            const float kd = exp2f((float)(127 - (t & 127)) * lg);
                            bf16_t* kt = KT + ((size_t)(b * NH + h) * HD + p0) * SEQ + t;
#pragma unroll
                            for (int e = 0; e < 4; ++e) { kt[(size_t)e * SEQ] = (bf16_t)f2bf(o1[e] * kd); kt[(size_t)(64 + e) * SEQ] = (bf16_t)f2bf(o2[e] * kd); }
                        }
                    } else if (region == 3) {
                        if (samp) { float* o = VS + (size_t)bs * RW + h * HD + p0; *(f32x4*)o = v0; *(f32x4*)(o + 64) = v1; }
                        else {
                            bf16_t* vt = VT + ((size_t)(b * NH + h) * HD + p0) * SEQ + t;
#pragma unroll
                            for (int e = 0; e < 4; ++e) { vt[(size_t)e * SEQ] = (bf16_t)f2bf(v0[e]); vt[(size_t)(64 + e) * SEQ] = (bf16_t)f2bf(v1[e]); }
                        }
                    } else {
                        bf16_t* dst = GATE + (size_t)r * RW + h * HD + p0;
                        *(u32x2*)dst = (u32x2){pk2(silu_f(v0[0]), silu_f(v0[1])), pk2(silu_f(v0[2]), silu_f(v0[3]))};
                        *(u32x2*)(dst + 64) = (u32x2){pk2(silu_f(v1[0]), silu_f(v1[1])), pk2(silu_f(v1[2]), silu_f(v1[3]))};
                    }
                }
            }
        }
    }
};
struct EpiRes {
    static constexpr bool PERM = false, AFTER_DRAIN = false;
    const float *xp, *xs; const float* mod; int gate_i; float* outy; int from_out;
    __device__ __forceinline__ void operator()(const f32x4 (&acc)[2][2][4][2], const pg8::Unit& u, int wr, int wc, int fr, int fq) const {
        asm volatile("" : "+v"(fr), "+v"(fq));
        const int c0 = u.pn * 256 + wc * 32 + fq * 4;
        const int nb = u.pm >> 3;
        const float* gp = mod + (size_t)nb * NMODC + gate_i * D + c0;
        f32x4 gv[2][2];
#pragma unroll
        for (int bj = 0; bj < 2; ++bj)
#pragma unroll
            for (int n = 0; n < 2; ++n) gv[bj][n] = *(const f32x4*)(gp + bj * 128 + n * 16);
#pragma unroll
        for (int ai = 0; ai < 2; ++ai)
#pragma unroll
            for (int mh = 0; mh < 2; ++mh) {
                f32x4 bv[2][2][2];
#pragma unroll
                for (int m2 = 0; m2 < 2; ++m2) {
                    const size_t r = (size_t)(u.pm * 256 + ai * 128 + wr * 64 + (mh * 2 + m2) * 16 + fr);
                    const float* base = (from_out ? outy : xp) + r * D + c0;
#pragma unroll
                    for (int bj = 0; bj < 2; ++bj)
#pragma unroll
                        for (int n = 0; n < 2; ++n) bv[m2][bj][n] = *(const f32x4*)(base + bj * 128 + n * 16);
                }
#pragma unroll
                for (int m2 = 0; m2 < 2; ++m2) {
                    const size_t r = (size_t)(u.pm * 256 + ai * 128 + wr * 64 + (mh * 2 + m2) * 16 + fr);
#pragma unroll
                    for (int bj = 0; bj < 2; ++bj)
#pragma unroll
                        for (int n = 0; n < 2; ++n) *(f32x4*)(outy + r * D + c0 + bj * 128 + n * 16) = bv[m2][bj][n] + gv[bj][n] * acc[ai][bj][mh * 2 + m2][n];
                }
            }
    }
};
struct EpiFfn {
    static constexpr bool PERM = false, AFTER_DRAIN = false;
    bf16_t* Gb; float *AT, *AH, *BH; const float *cw, *cb, *sconv; float* out; LAS float* tail;
    __device__ __forceinline__ void operator()(const f32x4 (&acc)[2][2][4][2], const pg8::Unit& u, int wr, int wc, int fr, int fq) const {
        asm volatile("" : "+v"(fr), "+v"(fq));
        const int lane = fq * 16 + fr, pm = u.pm;
        int ca[2];
#pragma unroll
        for (int n = 0; n < 2; ++n) ca[n] = 128 * u.pn + 32 * wc + 16 * n + 4 * fq;
        if (pm == MP / 256) {
#pragma unroll
            for (int m = 0; m < 4; ++m)
#pragma unroll
                for (int n = 0; n < 2; ++n) {
                    const int bs = wr * 64 + m * 16 + fr;
                    const f32x4 a = acc[0][0][m][n], bb = acc[0][1][m][n];
                    const f32x4 s0 = *(const f32x4*)(sconv + ((size_t)bs * 2 + 0) * DFF + ca[n]), s1 = *(const f32x4*)(sconv + ((size_t)bs * 2 + 1) * DFF + ca[n]);
                    const f32x4 w0 = *(const f32x4*)(cw + ca[n]), w1 = *(const f32x4*)(cw + DFF + ca[n]), w2 = *(const f32x4*)(cw + 2 * DFF + ca[n]), cbv = *(const f32x4*)(cb + ca[n]);
                    const f32x4 cv = w0 * s0 + w1 * s1 + w2 * a + cbv;
                    f32x4 g;
#pragma unroll
                    for (int e = 0; e < 4; ++e) g[e] = silu_f(cv[e]) * bb[e];
                    *(u32x2*)(Gb + (size_t)(MP + bs) * DFF + ca[n]) = (u32x2){pk2(g[0], g[1]), pk2(g[2], g[3])};
                    *(f32x4*)(out + O_CS + ((size_t)bs * 2 + 0) * DFF + ca[n]) = s1;
                    *(f32x4*)(out + O_CS + ((size_t)bs * 2 + 1) * DFF + ca[n]) = a;
                }
            return;
        }
        if (fr >= 14) {
#pragma unroll
            for (int ai = 0; ai < 2; ++ai)
#pragma unroll
                for (int n = 0; n < 2; ++n) {
                    const f32x4 v = acc[ai][0][3][n];
                    *(LAS f32x4*)(tail + (((ai * 2 + wr) * 4 + wc) * 2 + (fr - 14)) * 32 + 16 * n + 4 * fq) = v;
                    if (ai == 1 && wr == 1) {
                        *(f32x4*)(AT + ((size_t)pm * 2 + (fr - 14)) * DFF + ca[n]) = v;
                        if ((pm & 7) == 7) *(f32x4*)(out + O_CP + ((size_t)(pm >> 3) * 2 + (fr - 14)) * DFF + ca[n]) = v;
                    }
                }
        }
        LDS_SYNC();
#pragma unroll
        for (int n = 0; n < 2; ++n) {
            const int can = 128 * u.pn + 32 * wc + 16 * n + 4 * fq;
            const f32x4 w0 = *(const f32x4*)(cw + can), w1 = *(const f32x4*)(cw + DFF + can), w2 = *(const f32x4*)(cw + 2 * DFF + can), cbv = *(const f32x4*)(cb + can);
#pragma unroll
            for (int ai = 0; ai < 2; ++ai) {
                const int s = ai * 2 + wr;
                f32x4 prev = (f32x4){0.f, 0.f, 0.f, 0.f};
                if (s > 0 && fr >= 14) prev = *(const LAS f32x4*)(tail + ((((s - 1) * 4) + wc) * 2 + (fr - 14)) * 32 + 16 * n + 4 * fq);
#pragma unroll
                for (int m = 0; m < 4; ++m) {
                    const int r = pm * 256 + ai * 128 + wr * 64 + m * 16 + fr;
                    const bool top = (s == 0 && m == 0 && fr < 2 && (pm & 7) != 0);
                    const f32x4 cur = acc[ai][0][m][n], bb = acc[ai][1][m][n];
                    f32x4 g;
#pragma unroll
                    for (int e = 0; e < 4; ++e) {
                        const float c1 = __shfl(cur[e], lane - 1), c2 = __shfl(cur[e], lane - 2), q1 = __shfl(prev[e], lane + 15), q2 = __shfl(prev[e], lane + 14);
                        const float a1 = fr >= 1 ? c1 : q1, a2 = fr >= 2 ? c2 : q2;
                        g[e] = silu_f(w0[e] * a2 + w1[e] * a1 + w2[e] * cur[e] + cbv[e]) * bb[e];
                    }
                    if (top) { *(f32x4*)(AH + ((size_t)pm * 2 + fr) * DFF + can) = cur; *(f32x4*)(BH + ((size_t)pm * 2 + fr) * DFF + can) = bb; }
                    else *(u32x2*)(Gb + (size_t)r * DFF + can) = (u32x2){pk2(g[0], g[1]), pk2(g[2], g[3])};
                    prev = cur;
                    asm volatile("" ::: "memory");
                }
            }
        }
    }
};

__device__ __forceinline__ void phase3(LAS unsigned char* lds, int G, const bf16_t* U, const bf16_t* Q, const bf16_t* Kb, const bf16_t* KT, const bf16_t* VT, const bf16_t* GATE,
                                       const float* VS, const float* state_pool, const float* state_ret, const float* w_pool, const float* ls_pool,
                                       bf16_t* SPREV, bf16_t* MIX, float* out, int sel) {
    const int tid = threadIdx.x, lane = tid & 63, w = __builtin_amdgcn_readfirstlane(tid >> 6);
    const int vcu = (G % 8 == 0) ? ((int)blockIdx.x % 8) * (G / 8) + (int)blockIdx.x / 8 : (int)blockIdx.x;
    if (sel == 0 || sel == 1)
    for (int it = vcu; it < NBH * 16; it += G) {
        const int bh = it >> 4, dv0 = 32 * ((it >> 2) & 3), dk0 = 32 * (it & 3), h = bh % NH;
        int lf = lane; asm volatile("" : "+v"(lf));
        const int fr = lf & 15, fq = lf >> 4;
        const float gC = exp2f(128.f * lg2_gamma(h));
        LAS float* kv = (LAS float*)lds;
        const bf16_t* vt = VT + ((size_t)bh * HD + dv0 + fr) * SEQ + (2 * w) * 128 + fq * 8;
        const bf16_t* kt = KT + ((size_t)bh * HD + dk0 + fr) * SEQ + (2 * w) * 128 + fq * 8;
        bf16x8 Af[2][2][4], Bf[2][2][4];
#pragma unroll
        for (int ci = 0; ci < 2; ++ci)
#pragma unroll
            for (int mt = 0; mt < 2; ++mt)
#pragma unroll
                for (int ks = 0; ks < 4; ++ks) { Af[ci][mt][ks] = *(const bf16x8*)(vt + (size_t)(16 * mt) * SEQ + ci * 128 + ks * 32); Bf[ci][mt][ks] = *(const bf16x8*)(kt + (size_t)(16 * mt) * SEQ + ci * 128 + ks * 32); }
#pragma unroll
        for (int ci = 0; ci < 2; ++ci)
#pragma unroll
            for (int nt = 0; nt < 2; ++nt)
#pragma unroll
                for (int mt = 0; mt < 2; ++mt) {
                    f32x4 a = (f32x4){0.f, 0.f, 0.f, 0.f};
#pragma unroll
                    for (int ks = 0; ks < 4; ++ks) a = mfma16(Bf[ci][nt][ks], Af[ci][mt][ks], a);
                    *(LAS f32x4*)(kv + ((2 * w + ci) * 32 + 16 * mt + fr) * 36 + 16 * nt + 4 * fq) = a;
                }
        LDS_SYNC();
        {
            const int dv = tid >> 4, dk2 = (tid & 15) * 2;
            float s0 = 0.f, s1 = 0.f;
            bf16_t* sp = SPREV + (((size_t)bh * NCH) * HD + dv0 + dv) * HD + dk0 + dk2;
#pragma unroll 4
            for (int c = 0; c < NCH; ++c) {
                *(unsigned*)(sp + (size_t)c * HD * HD) = pk2(s0, s1);
                const LAS float* kp = kv + (c * 32 + dv) * 36 + dk2;
                s0 = s0 * gC + kp[0]; s1 = s1 * gC + kp[1];
            }
            float* o = out + O_RP + ((size_t)bh * HD + dk0 + dk2) * HD + dv0 + dv;
            o[0] = s0; o[HD] = s1;
        }
        LDS_SYNC();
    }
    if (sel == 0 || sel == 2)
    for (int id = blockIdx.x; id < BS * NH; id += G) {
        const int bs = id / NH, h = id % NH, row = MP + bs;
        const float gam = 1.0f - exp2f(-5.0f - (float)h);
        LAS float* red = (LAS float*)lds;
        LAS float* qv = red + 16 * 128;
        const int dkg = tid >> 5, c4 = tid & 31;
        const float* s0p = state_ret + (((size_t)bs * NH + h) * HD + dkg * 8) * HD + 4 * c4;
        f32x4 sv[8];
#pragma unroll
        for (int i = 0; i < 8; ++i) sv[i] = *(const f32x4*)(s0p + (size_t)i * HD);
        const f32x4 v4 = *(const f32x4*)(VS + (size_t)bs * RW + h * HD + 4 * c4);
        if (tid < 256) { const int i = tid & 127; qv[tid] = bf2f((tid < 128 ? Q : Kb)[(size_t)row * RW + h * HD + i]); }
        float vsl[2] = {0.f, 0.f}, gtl[2] = {0.f, 0.f};
        if (w == 0) {
#pragma unroll
            for (int i = 0; i < 2; ++i) { vsl[i] = VS[(size_t)bs * RW + h * HD + lane + 64 * i]; gtl[i] = bf2f(GATE[(size_t)row * RW + h * HD + lane + 64 * i]); }
        }
        LDS_SYNC();
        float* sn = out + O_RS + (((size_t)bs * NH + h) * HD + dkg * 8) * HD + 4 * c4;
        f32x4 part = (f32x4){0.f, 0.f, 0.f, 0.f};
#pragma unroll
        for (int i = 0; i < 8; ++i) {
            const float qd = qv[dkg * 8 + i], kd = qv[128 + dkg * 8 + i];
            part = part + sv[i] * qd;
            *(f32x4*)(sn + (size_t)i * HD) = sv[i] * gam + v4 * kd;
        }
        *(LAS f32x4*)(red + dkg * 128 + 4 * c4) = part;
        LDS_SYNC();
        if (w == 0) {
            float qk = 0.f;
#pragma unroll
            for (int i = 0; i < 2; ++i) qk += qv[lane + 64 * i] * qv[128 + lane + 64 * i];
            qk = wave_sum(qk);
            float o[2], s1 = 0.f;
#pragma unroll
            for (int i = 0; i < 2; ++i) { const int dv = lane + 64 * i; float a = 0.f;
#pragma unroll
                for (int g = 0; g < 16; ++g) a += red[g * 128 + dv];
                o[i] = qk * vsl[i] + gam * a; s1 += o[i]; }
            const float mu = wave_sum(s1) * (1.f / HD);
            float s2 = 0.f;
#pragma unroll
            for (int i = 0; i < 2; ++i) { o[i] -= mu; s2 += o[i] * o[i]; }
            const float rstd = rsqrtf(wave_sum(s2) * (1.f / HD) + EPS);
#pragma unroll
            for (int i = 0; i < 2; ++i) MIX[(size_t)row * D + PW + h * HD + lane + 64 * i] = (bf16_t)f2bf(o[i] * rstd * gtl[i]);
        }
        LDS_SYNC();
    }
    if (sel == 0 || sel == 3) {
        const int d = tid & 63, g = (tid >> 6) & 3, half = tid >> 8;
        float wc[64];
#pragma unroll
        for (int c = 0; c < 64; ++c) wc[c] = w_pool[(size_t)(g * 64 + c) * 64 + d];
        const float ls = ls_pool[g * 64 + d];
        LAS float* ub = (LAS float*)lds;
        LAS float* pb = ub + 47 * 256;
        for (int it = blockIdx.x; it < MP / 32 + BS / 8; it += G) {
            int ntok, row0;
            if (it < MP / 32) {
                const int r0 = it * 32, t0 = r0 & (SEQ - 1);
                ntok = 32; row0 = r0;
                u32x4 raw[3];
#pragma unroll
                for (int i = 0; i < 3; ++i) { const int idx = tid + 512 * i, rr = idx >> 5, c8 = idx & 31; raw[i] = (u32x4){0u, 0u, 0u, 0u};
                    if (idx < 47 * 32 && t0 - 15 + rr >= 0) raw[i] = *(const u32x4*)(U + (size_t)(r0 - 15 + rr) * PW + c8 * 8); }
#pragma unroll
                for (int i = 0; i < 3; ++i) { const int idx = tid + 512 * i, rr = idx >> 5, c8 = idx & 31;
                    if (idx < 47 * 32) { LAS f32x4* dst = (LAS f32x4*)(ub + rr * 256 + c8 * 8);
                        dst[0] = (f32x4){bf2f(raw[i].x & 0xffffu), bf2f(raw[i].x >> 16), bf2f(raw[i].y & 0xffffu), bf2f(raw[i].y >> 16)};
                        dst[1] = (f32x4){bf2f(raw[i].z & 0xffffu), bf2f(raw[i].z >> 16), bf2f(raw[i].w & 0xffffu), bf2f(raw[i].w >> 16)}; } }
                LDS_SYNC();
                { const int ch = tid & 255, gg = ch >> 6, wn = 2 << gg;
#pragma unroll 1
                  for (int i = 0; i < 16; ++i) { const int tt = (tid >> 8) * 16 + i; float s = 0.f;
                      for (int k = 0; k < wn; ++k) s += ub[(15 + tt - k) * 256 + ch];
                      const int cnt = min(wn, t0 + tt + 1);
                      pb[tt * 256 + ch] = s / (float)cnt - ub[(15 + tt) * 256 + ch]; } }
            } else {
                const int s0i = (it - MP / 32) * 8;
                ntok = 8; row0 = MP + s0i;
                const int sidx = tid >> 6, c4 = tid & 63, bs = s0i + sidx, wn = 2 << (c4 >> 4);
                f32x4 hv[15];
#pragma unroll
                for (int j = 0; j < 15; ++j) hv[j] = *(const f32x4*)(state_pool + ((size_t)bs * 15 + j) * PW + 4 * c4);
                const u32x2 ur = *(const u32x2*)(U + (size_t)(MP + bs) * PW + 4 * c4);
                const f32x4 un = (f32x4){bf2f(ur.x & 0xffffu), bf2f(ur.x >> 16), bf2f(ur.y & 0xffffu), bf2f(ur.y >> 16)};
                f32x4 sm = un;
#pragma unroll
                for (int j = 0; j < 15; ++j) { if (j >= 16 - wn) sm = sm + hv[j];
                    if (j >= 1) *(f32x4*)(out + O_PS + ((size_t)bs * 15 + j - 1) * PW + 4 * c4) = hv[j]; }
                *(LAS f32x4*)(pb + sidx * 256 + 4 * c4) = sm * (1.0f / (float)wn) - un;
            }
            LDS_SYNC();
            const int per = ntok >> 1;
            for (int tt = half * per; tt < (half + 1) * per; ++tt) {
                const LAS f32x4* pp = (const LAS f32x4*)(pb + tt * 256 + g * 64);
                float y = 0.f;
#pragma unroll
                for (int c4 = 0; c4 < 16; ++c4) { const f32x4 p4 = pp[c4]; y += p4[0] * wc[4 * c4] + p4[1] * wc[4 * c4 + 1] + p4[2] * wc[4 * c4 + 2] + p4[3] * wc[4 * c4 + 3]; }
                MIX[(size_t)(row0 + tt) * D + g * 64 + d] = (bf16_t)f2bf(y * ls);
            }
            LDS_SYNC();
        }
    }
}

template <int K> __device__ __forceinline__ void sample_proj_item(LAS unsigned char* lds, int item, const bf16_t* A, const bf16_t* Bt, const float* base, const float* mod, int gate_i, float* outy) {
    constexpr int KS = K / 8, NST = KS / 32, NB = 6;
    const int tid = threadIdx.x, w = __builtin_amdgcn_readfirstlane(tid >> 6);
    int lf = tid & 63; asm volatile("" : "+v"(lf));
    const int fr = lf & 15, fq = lf >> 4;
    const int n0 = (item >> 1) * 16, m0 = (item & 1) * 64;
    const bf16_t* ap = A + (size_t)(MP + m0 + fr) * K + w * KS + fq * 8;
    const bf16_t* bp = Bt + (size_t)(n0 + fr) * K + w * KS + fq * 8;
    f32x4 acc[4];
#pragma unroll
    for (int mt = 0; mt < 4; ++mt) acc[mt] = (f32x4){0.f, 0.f, 0.f, 0.f};
#pragma unroll
    for (int s0 = 0; s0 < NST; s0 += NB) {
        bf16x8 bfr[NB], afr[NB][4];
#pragma unroll
        for (int i = 0; i < NB; ++i) if (s0 + i < NST) { bfr[i] = *(const bf16x8*)(bp + (s0 + i) * 32);
#pragma unroll
            for (int mt = 0; mt < 4; ++mt) afr[i][mt] = *(const bf16x8*)(ap + (size_t)(16 * mt) * K + (s0 + i) * 32); }
#pragma unroll
        for (int i = 0; i < NB; ++i) if (s0 + i < NST) {
#pragma unroll
            for (int mt = 0; mt < 4; ++mt) acc[mt] = mfma16(bfr[i], afr[i][mt], acc[mt]);
        }
    }
    LAS f32x4* xr = (LAS f32x4*)lds;
#pragma unroll
    for (int mt = 0; mt < 4; ++mt) xr[(w * 4 + mt) * 64 + lf] = acc[mt];
    LDS_SYNC();
    if (tid < 256) {
        const int mt = tid >> 6;
        f32x4 v = xr[mt * 64 + lf];
#pragma unroll
        for (int ww = 1; ww < 8; ++ww) v = v + xr[(ww * 4 + mt) * 64 + lf];
        const int m = m0 + 16 * mt + fr, c = n0 + 4 * fq;
        const f32x4 bv = *(const f32x4*)(base + (size_t)m * D + c), gv = *(const f32x4*)(mod + (size_t)(BP + m) * NMODC + gate_i * D + c);
        *(f32x4*)(outy + (size_t)(MP + m) * D + c) = bv + gv * v;
    }
    LDS_SYNC();
}

constexpr int RT_STRIDE = 272, RT_TILE = 128 * RT_STRIDE;
__device__ __forceinline__ bf16x8 rt_frag(const LAS unsigned char* tile, int row, int kel) { return *(const LAS bf16x8*)(tile + row * RT_STRIDE + kel * 2); }
__device__ __forceinline__ void p4_issue(u32x4 (&pf)[16], int it, int tid, const bf16_t* Q, const bf16_t* Kb, const bf16_t* VT, const bf16_t* SPREV) {
    const int bh = it / NCH, c = it % NCH, b = bh / NH, h = bh % NH;
    const size_t row0 = (size_t)b * SEQ + c * 128;
#pragma unroll
    for (int i = 0; i < 4; ++i) {
        const int idx = tid + 512 * i, row = idx >> 4, ch = idx & 15;
        pf[i]      = *(const u32x4*)(Q + (row0 + row) * RW + h * HD + ch * 8);
        pf[4 + i]  = *(const u32x4*)(Kb + (row0 + row) * RW + h * HD + ch * 8);
        pf[8 + i]  = *(const u32x4*)(VT + ((size_t)bh * HD + row) * SEQ + c * 128 + ch * 8);
        pf[12 + i] = *(const u32x4*)(SPREV + (((size_t)bh * NCH + c) * HD + row) * HD + ch * 8);
    }
}
__device__ __forceinline__ void phase4(LAS unsigned char* lds, int G, const bf16_t* Q, const bf16_t* Kb, const bf16_t* VT, const bf16_t* SPREV, const bf16_t* GATE, bf16_t* MIX,
                                       const bf16_t* WTout, const float* x_s, const float* mod, float* outy) {
    const int tid = threadIdx.x, lane = tid & 63, w = __builtin_amdgcn_readfirstlane(tid >> 6), wr = w >> 2, wc = w & 3;
    LAS unsigned char* Tq = lds; LAS unsigned char* Tk = lds + RT_TILE; LAS unsigned char* Tv = lds + 2 * RT_TILE; LAS unsigned char* Ts = lds + 3 * RT_TILE;
    LAS float* red1 = (LAS float*)(lds + 4 * RT_TILE); LAS float* red2 = red1 + 512;
    u32x4 pf[16];
    if ((int)blockIdx.x < NBH * NCH) p4_issue(pf, blockIdx.x, tid, Q, Kb, VT, SPREV);
    for (int it = blockIdx.x; it < NBH * NCH; it += G) {
        const int bh = it / NCH, c = it % NCH, b = bh / NH, h = bh % NH;
        int lf = lane; asm volatile("" : "+v"(lf));
        const int fr = lf & 15, fq = lf >> 4;
        const float lg = lg2_gamma(h);
        const size_t row0 = (size_t)b * SEQ + c * 128;
#pragma unroll
        for (int i = 0; i < 4; ++i) {
            const int idx = tid + 512 * i, row = idx >> 4, ch = idx & 15;
            *(LAS u32x4*)(Tq + row * RT_STRIDE + ch * 16) = pf[i]; *(LAS u32x4*)(Tk + row * RT_STRIDE + ch * 16) = pf[4 + i];
            *(LAS u32x4*)(Tv + row * RT_STRIDE + ch * 16) = pf[8 + i]; *(LAS u32x4*)(Ts + row * RT_STRIDE + ch * 16) = pf[12 + i];
        }
        LDS_SYNC();
        if (it + G < NBH * NCH) p4_issue(pf, it + G, tid, Q, Kb, VT, SPREV);
        u32x2 gt[4][2];
#pragma unroll
        for (int mt = 0; mt < 4; ++mt)
#pragma unroll
            for (int nt = 0; nt < 2; ++nt) gt[mt][nt] = *(const u32x2*)(GATE + (row0 + 64 * wr + 16 * mt + fr) * RW + h * HD + 32 * wc + 16 * nt + 4 * fq);
        f32x4 sa[4][2], o[4][2];
#pragma unroll
        for (int mt = 0; mt < 4; ++mt)
#pragma unroll
            for (int nt = 0; nt < 2; ++nt) { sa[mt][nt] = (f32x4){0.f, 0.f, 0.f, 0.f}; o[mt][nt] = sa[mt][nt]; }
#pragma unroll 1
        for (int ks = 0; ks < 4; ++ks) {
            bf16x8 a[4], bk[2], bs[2];
#pragma unroll
            for (int mt = 0; mt < 4; ++mt) a[mt] = rt_frag(Tq, 64 * wr + 16 * mt + fr, ks * 32 + fq * 8);
#pragma unroll
            for (int nt = 0; nt < 2; ++nt) { bk[nt] = rt_frag(Tk, 32 * wc + 16 * nt + fr, ks * 32 + fq * 8); bs[nt] = rt_frag(Ts, 32 * wc + 16 * nt + fr, ks * 32 + fq * 8); }
#pragma unroll
            for (int mt = 0; mt < 4; ++mt)
#pragma unroll
                for (int nt = 0; nt < 2; ++nt) { sa[mt][nt] = mfma16(bk[nt], a[mt], sa[mt][nt]); o[mt][nt] = mfma16(bs[nt], a[mt], o[mt][nt]); }
        }
        LDS_SYNC();
#pragma unroll
        for (int mt = 0; mt < 4; ++mt) {
            const int i = 64 * wr + 16 * mt + fr;
            const float qd = exp2f((float)(i + 1) * lg);
#pragma unroll
            for (int nt = 0; nt < 2; ++nt) {
                const int j0 = 32 * wc + 16 * nt + 4 * fq;
                float mv[4];
#pragma unroll
                for (int e = 0; e < 4; ++e) { const int dl = i - (j0 + e); mv[e] = dl >= 0 ? sa[mt][nt][e] * exp2f((float)dl * lg) : 0.f; }
                *(LAS u32x2*)(Tk + i * RT_STRIDE + j0 * 2) = (u32x2){pk2(mv[0], mv[1]), pk2(mv[2], mv[3])};
                o[mt][nt] = o[mt][nt] * qd;
            }
        }
        LDS_SYNC();
#pragma unroll 1
        for (int ks = 0; ks < 4; ++ks) {
            if (32 * ks > 64 * wr + 63) continue;
            bf16x8 a[4], bv[2];
#pragma unroll
            for (int mt = 0; mt < 4; ++mt) a[mt] = rt_frag(Tk, 64 * wr + 16 * mt + fr, ks * 32 + fq * 8);
#pragma unroll
            for (int nt = 0; nt < 2; ++nt) bv[nt] = rt_frag(Tv, 32 * wc + 16 * nt + fr, ks * 32 + fq * 8);
#pragma unroll
            for (int mt = 0; mt < 4; ++mt)
#pragma unroll
                for (int nt = 0; nt < 2; ++nt) o[mt][nt] = mfma16(bv[nt], a[mt], o[mt][nt]);
        }
#pragma unroll
        for (int mt = 0; mt < 4; ++mt) {
            float s = ((o[mt][0][0] + o[mt][0][1]) + (o[mt][0][2] + o[mt][0][3])) + ((o[mt][1][0] + o[mt][1][1]) + (o[mt][1][2] + o[mt][1][3]));
            s += __shfl_xor(s, 16); s += __shfl_xor(s, 32);
            if (fq == 0) red1[(64 * wr + 16 * mt + fr) * 4 + wc] = s;
        }
        LDS_SYNC();
#pragma unroll
        for (int mt = 0; mt < 4; ++mt) {
            const int i = 64 * wr + 16 * mt + fr;
            const f32x4 rs = *(const LAS f32x4*)(red1 + i * 4);
            const float mu = ((rs[0] + rs[1]) + (rs[2] + rs[3])) * (1.f / HD);
            o[mt][0] = o[mt][0] - mu; o[mt][1] = o[mt][1] - mu;
            float s = 0.f;
#pragma unroll
            for (int nt = 0; nt < 2; ++nt)
#pragma unroll
                for (int e = 0; e < 4; ++e) s += o[mt][nt][e] * o[mt][nt][e];
            s += __shfl_xor(s, 16); s += __shfl_xor(s, 32);
            if (fq == 0) red2[i * 4 + wc] = s;
        }
        LDS_SYNC();
#pragma unroll
        for (int mt = 0; mt < 4; ++mt) {
            const int i = 64 * wr + 16 * mt + fr;
            const f32x4 rs = *(const LAS f32x4*)(red2 + i * 4);
            const float rstd = rsqrtf(((rs[0] + rs[1]) + (rs[2] + rs[3])) * (1.f / HD) + EPS);
#pragma unroll
            for (int nt = 0; nt < 2; ++nt) {
                const u32x2 g2 = gt[mt][nt];
                const f32x4 y = o[mt][nt] * rstd;
                *(u32x2*)(MIX + (row0 + i) * D + PW + h * HD + 32 * wc + 16 * nt + 4 * fq) =
                    (u32x2){pk2(y[0] * bf2f(g2.x & 0xffffu), y[1] * bf2f(g2.x >> 16)), pk2(y[2] * bf2f(g2.y & 0xffffu), y[3] * bf2f(g2.y >> 16))};
            }
        }
        LDS_SYNC();
    }
    for (int it = G - 1 - (int)blockIdx.x; it < D / 8; it += G) sample_proj_item<D>(lds, it, MIX, WTout, x_s, mod, 2, outy);
}

__device__ __forceinline__ void phase_fix(LAS unsigned char* lds, int G, const float* AT, const float* AH, const float* BH, const float* cw, const float* cb, bf16_t* Gb,
                                          const bf16_t* WTfo, const float* mod, float* outy) {
    for (int it = G - 1 - (int)blockIdx.x; it < D / 8; it += G) sample_proj_item<DFF>(lds, it, Gb, WTfo, outy + (size_t)MP * D, mod, 5, outy);
    const int total = 64 * 2 * DFF;
    for (int idx = blockIdx.x * 512 + threadIdx.x; idx < total; idx += G * 512) {
        const int pm = idx / (2 * DFF), rem = idx % (2 * DFF), rr = rem / DFF, c = rem % DFF;
        if ((pm & 7) == 0) continue;
        const float a_m1 = rr == 0 ? AT[((size_t)(pm - 1) * 2 + 1) * DFF + c] : AH[((size_t)pm * 2 + 0) * DFF + c];
        const float a_m2 = rr == 0 ? AT[((size_t)(pm - 1) * 2 + 0) * DFF + c] : AT[((size_t)(pm - 1) * 2 + 1) * DFF + c];
        const float a0 = AH[((size_t)pm * 2 + rr) * DFF + c], bb = BH[((size_t)pm * 2 + rr) * DFF + c];
        const float cv = cw[c] * a_m2 + cw[DFF + c] * a_m1 + cw[2 * DFF + c] * a0 + cb[c];
        Gb[((size_t)pm * 256 + rr) * DFF + c] = (bf16_t)f2bf(silu_f(cv) * bb);
    }
}

#define XB_TMO      128
#define XB_XCNT(j)  (256  + 64 * (j))
#define XB_XSUB(j)  (1280 + 64 * (j))
#define XB_XGEN(j)  (2304 + 64 * (j))
#define XB_TOP      3328
#define XB_TOPGEN   3392
#define XCD_BAR_WORDS 3456
#define XB_SPIN_CAP (1u << 18)

__device__ __forceinline__ unsigned xb_ld(unsigned* p)              { return __hip_atomic_load(p, __ATOMIC_RELAXED, __HIP_MEMORY_SCOPE_AGENT); }
__device__ __forceinline__ unsigned xb_add(unsigned* p, unsigned v) { return __hip_atomic_fetch_add(p, v, __ATOMIC_RELAXED, __HIP_MEMORY_SCOPE_AGENT); }
__device__ __forceinline__ unsigned xb_xcc_id() { return (unsigned)__builtin_amdgcn_s_getreg((3 << 11) | 20) & 0xFu; }
#define XB_SPIN(cond, bar) do { unsigned _sp = 0; while (cond) { __builtin_amdgcn_s_sleep(1); \
    if ((++_sp & 255u) == 0u) { if (xb_ld(&(bar)[XB_TMO])) break; if (_sp > XB_SPIN_CAP) { atomicAdd(&(bar)[XB_TMO], 1u); break; } } } } while (0)

struct XcdBarrier {
    unsigned* bar; unsigned x;
    volatile LAS unsigned* st;
};

__device__ __forceinline__ XcdBarrier xcd_barrier_post(unsigned* bar, volatile LAS unsigned* st) {
    XcdBarrier b; b.bar = bar; b.x = xb_xcc_id(); b.st = st;
    if (threadIdx.x == 0) (void)xb_add(&bar[XB_XCNT(b.x)], 1u);
    return b;
}
__device__ __forceinline__ void xcd_barrier_complete(unsigned* bar, unsigned x, unsigned& nloc, unsigned& nx) {
    const unsigned G = gridDim.x * gridDim.y * gridDim.z;
    unsigned sum, cnt, mine, sp = 0u;
    for (;;) {
        sum = 0u; cnt = 0u; mine = 0u;
#pragma unroll
        for (unsigned j = 0; j < 16; ++j) { const unsigned c = xb_ld(&bar[XB_XCNT(j)]); sum += c; cnt += (c > 0u) ? 1u : 0u; mine = (j == x) ? c : mine; }
        if (sum == G) break;
        __builtin_amdgcn_s_sleep(1);
        if ((++sp & 255u) == 0u) { if (xb_ld(&bar[XB_TMO])) break; if (sp > XB_SPIN_CAP) { atomicAdd(&bar[XB_TMO], 1u); break; } }
    }
    nloc = mine > 0u ? mine : 1u; nx = cnt > 0u ? cnt : 1u;
}

__device__ __forceinline__ void xcd_barrier(const XcdBarrier& b) {
    asm volatile("s_waitcnt vmcnt(0)" ::: "memory");
    __syncthreads();
    if (threadIdx.x == 0) {
        unsigned* bar = b.bar;
        __builtin_amdgcn_s_waitcnt(0);
        unsigned nloc = b.st[0], nx = b.st[1];
        if (nloc == 0u) { xcd_barrier_complete(bar, b.x, nloc, nx); b.st[0] = nloc; b.st[1] = nx; }
        const unsigned old = xb_add(&bar[XB_XSUB(b.x)], 1u);
        const unsigned gen = old / nloc;
        if (old + 1u == (gen + 1u) * nloc) {
            __builtin_amdgcn_fence(__ATOMIC_RELEASE, "agent");
            asm volatile("s_waitcnt vmcnt(0)" ::: "memory");
            const unsigned og = xb_add(&bar[XB_TOP], 1u);
            const unsigned tg = og / nx;
            if (og + 1u == (tg + 1u) * nx) xb_add(&bar[XB_TOPGEN], 1u);
            else XB_SPIN(xb_ld(&bar[XB_TOPGEN]) == tg, bar);
            __builtin_amdgcn_fence(__ATOMIC_ACQUIRE, "agent");
            xb_add(&bar[XB_XGEN(b.x)], 1u);
            asm volatile("s_waitcnt vmcnt(0)" ::: "memory");
        } else {
            XB_SPIN(xb_ld(&bar[XB_XGEN(b.x)]) == gen, bar);
            __builtin_amdgcn_fence(__ATOMIC_ACQUIRE, "agent");
            asm volatile("s_waitcnt vmcnt(0)" ::: "memory");
        }
    }
    __syncthreads();
}


struct Args { const float* in[20]; float* out; unsigned char* ws; int ph_lo, ph_hi; };
__global__ void __launch_bounds__(512, 2) hymba_fwd(Args args) {
    extern __shared__ __attribute__((aligned(16))) unsigned char lds_raw[];
    LAS unsigned char* lds = (LAS unsigned char*)lds_raw;
    cg::grid_group grid = cg::this_grid();
    const int G = gridDim.x;
    unsigned char* ws = args.ws; float* out = args.out;
    const float *x_p = args.in[0], *x_s = args.in[1], *c_p = args.in[2], *c_s = args.in[3], *st_pool = args.in[4], *st_ret = args.in[5], *st_conv = args.in[6],
                *g_mix = args.in[7], *g_ffn = args.in[8], *w_ada = args.in[9], *b_ada = args.in[10], *w_in = args.in[11], *w_pool = args.in[12], *ls_pool = args.in[13],
                *w_out = args.in[14], *w_fi = args.in[15], *conv_w = args.in[16], *conv_b = args.in[17], *w_fo = args.in[18], *g_fin = args.in[19];
    float* mod = (float*)(ws + WS_MOD); float* rope = (float*)(ws + WS_ROPE); float* VS = (float*)(ws + WS_VS);
    bf16_t *WTin = (bf16_t*)(ws + WS_WIN), *WTout = (bf16_t*)(ws + WS_WOUT), *WTfi = (bf16_t*)(ws + WS_WFI), *WTfo = (bf16_t*)(ws + WS_WFO);
    float *AT = (float*)(ws + WS_HALO), *AH = AT + HALO_N, *BH = AH + HALO_N;
    bf16_t *RA = (bf16_t*)(ws + WS_RA), *RB = (bf16_t*)(ws + WS_RB), *Ub = (bf16_t*)(ws + WS_U), *GATE = (bf16_t*)(ws + WS_GATE), *Qb = (bf16_t*)(ws + WS_Q), *Kb = (bf16_t*)(ws + WS_K),
           *KT = (bf16_t*)(ws + WS_KT), *VT = (bf16_t*)(ws + WS_VT), *Gb = (bf16_t*)(ws + WS_G);
    bf16_t* SPREV = (bf16_t*)(out + O_YP);
    const int lo = args.ph_lo, hi = args.ph_hi;
#if MK_XCD_BARRIER && !MK_MULTI_LAUNCH
    volatile LAS unsigned* bst = (volatile LAS unsigned*)(lds + LDS_BYTES - 64);
    if (threadIdx.x < 4) bst[threadIdx.x] = 0u;
    __syncthreads();
    XcdBarrier xbar = xcd_barrier_post((unsigned*)(ws + WS_CTL), bst);
#endif
#ifndef PH_MASK
#define PH_MASK 0x7ff
#endif
#define IN(k) (((PH_MASK >> (k)) & 1) && lo <= (k) && (k) < hi)
#if MK_XCD_BARRIER && !MK_MULTI_LAUNCH
#define SEAM(k) do { if (IN(k) && IN((k) + 1)) { if (lo < 0) grid.sync(); else xcd_barrier(xbar); } } while (0)
#define SEAMX() xcd_barrier(xbar)
#else
#define SEAM(k) do { if (IN(k) && IN((k) + 1)) { grid.sync(); } } while (0)
#define SEAMX() grid.sync()
#endif

#ifndef PROBE_REP
#define PROBE_REP (-1)
#endif
#define PHASE(k, ...) do { if (IN(k)) { __VA_ARGS__; if (PROBE_REP == (k)) { SEAMX(); __VA_ARGS__; } } } while (0)
    PHASE(0, phase0(lds, G, c_p, c_s, w_ada, b_ada, w_in, w_out, w_fi, w_fo, mod, rope, WTin, WTout, WTfi, WTfo));
    SEAM(0);
    PHASE(1, norm_phase<0>(G, x_p, x_s, g_mix, mod, 0, 1, RA, nullptr));
    SEAM(1);
    PHASE(2, {
        pg8::Gemm g{RA, WTin, MPAD, INC, D}; pg8::StaticOrder S; S.init(MPAD, INC, G, (int)blockIdx.x);
        EpiIn E{Ub, Qb, Kb, KT, VT, GATE, VS, rope, out};
        pg8::gemm_phase<EpiIn, pg8::StaticOrder, true, true>(lds, g, S, E);
    });
    SEAM(2);
    #ifndef PROBE_SUB
#define PROBE_SUB 0
#endif
    if (IN(3)) { phase3(lds, G, Ub, Qb, Kb, KT, VT, GATE, VS, st_pool, st_ret, w_pool, ls_pool, SPREV, RB, out, 0);
        if (PROBE_SUB) { SEAMX(); phase3(lds, G, Ub, Qb, Kb, KT, VT, GATE, VS, st_pool, st_ret, w_pool, ls_pool, SPREV, RB, out, PROBE_SUB); } }
    SEAM(3);
    PHASE(4, phase4(lds, G, Qb, Kb, VT, SPREV, GATE, RB, WTout, x_s, mod, out + O_YP));
    SEAM(4);
    PHASE(5, {
        pg8::Gemm g{RB, WTout, MP, D, D}; pg8::StaticOrder S; S.init(MP, D, G, (int)blockIdx.x);
        EpiRes E{x_p, x_s, mod, 2, out + O_YP, 0};
        pg8::gemm_phase<EpiRes, pg8::StaticOrder, true, true>(lds, g, S, E);
    });
    SEAM(5);
    PHASE(6, norm_phase<1>(G, nullptr, nullptr, g_ffn, mod, 3, 4, RA, out + O_YP));
    SEAM(6);
    PHASE(7, {
        pg8::Gemm g{RA, WTfi, MPAD, NFF, D}; pg8::StaticOrder S; S.init(MPAD, NFF, G, (int)blockIdx.x);
        EpiFfn E{Gb, AT, AH, BH, conv_w, conv_b, st_conv, out, (LAS float*)(lds + LDS_X)};
        pg8::gemm_phase<EpiFfn, pg8::StaticOrder, true, true>(lds, g, S, E);
    });
    SEAM(7);
    PHASE(8, phase_fix(lds, G, AT, AH, BH, conv_w, conv_b, Gb, WTfo, mod, out + O_YP));
    SEAM(8);
    PHASE(9, {
        pg8::Gemm g{Gb, WTfo, MP, D, DFF}; pg8::StaticOrder S; S.init(MP, D, G, (int)blockIdx.x);
        EpiRes E{nullptr, nullptr, mod, 5, out + O_YP, 1};
        pg8::gemm_phase<EpiRes, pg8::StaticOrder, true, true>(lds, g, S, E);
    });
    SEAM(9);
    PHASE(10, norm_phase<2>(G, nullptr, nullptr, g_fin, nullptr, 0, 0, nullptr, out + O_YP));
#undef PHASE
#undef IN
#undef SEAM
#undef SEAMX
}

extern "C" void kernel_launch(void* const* d_in, const int* in_sizes, int n_in, void* d_out, int out_size, void* d_ws, size_t ws_size, hipStream_t stream) {
    static int grid = 0;
    if (grid == 0) {
        if (n_in != 20 || (size_t)out_size != O_END || ws_size < WS_END) { fprintf(stderr, "kernel_launch: unexpected problem shape (n_in %d, out %d, ws %zu)\n", n_in, out_size, ws_size); grid = -1; return; }
        int dev = 0, cus = 0, per_cu = 0;
        (void)hipGetDevice(&dev); (void)hipDeviceGetAttribute(&cus, hipDeviceAttributeMultiprocessorCount, dev);
        if (hipFuncSetAttribute((const void*)hymba_fwd, hipFuncAttributeMaxDynamicSharedMemorySize, LDS_BYTES) != hipSuccess) { fprintf(stderr, "kernel_launch: hipFuncSetAttribute failed\n"); grid = -1; return; }
        if (hipOccupancyMaxActiveBlocksPerMultiprocessor(&per_cu, (const void*)hymba_fwd, 512, LDS_BYTES) != hipSuccess || per_cu < 1) per_cu = 1;
        (void)hipGetLastError();
        grid = cus * per_cu;
        if (grid <= 0) grid = 256;
    }
    if (grid < 0) return;
    Args a{};
    for (int i = 0; i < 20; ++i) a.in[i] = (const float*)d_in[i];
    a.out = (float*)d_out; a.ws = (unsigned char*)d_ws;
#if MK_MULTI_LAUNCH
    for (int ph = 0; ph < NPHASE; ++ph) { a.ph_lo = ph; a.ph_hi = ph + 1; hipLaunchKernelGGL(hymba_fwd, dim3(grid), dim3(512), LDS_BYTES, stream, a); }
#else
    a.ph_lo = 0; a.ph_hi = NPHASE;
#if MK_XCD_BARRIER
    (void)hipMemsetAsync((char*)d_ws + WS_CTL, 0, 16384, stream);
#endif
    void* kargs[] = {&a};
    hipError_t e = hipLaunchCooperativeKernel((const void*)hymba_fwd, dim3(grid), dim3(512), kargs, LDS_BYTES, stream);
    if (e != hipSuccess) fprintf(stderr, "kernel_launch: cooperative launch failed: %s (grid %d)\n", hipGetErrorString(e), grid);
#endif
}
```
